# Optimizing an MI355X kernel written in HIP

```python
import jax
import jax.numpy as jnp
from jax import lax
import numpy as np

D_MODEL = 1024
BATCH = 4
SEQ = 8192
DEPTH = 2
DEC_BATCH = 32
DEC_SEQ = 1
PAST_LEN = 16384
PAGE_SIZE = 128

HEAD_DIM = 64
DILATED_GROUPS = ((128, 1), (512, 4), (2048, 16))
N_DIL = len(DILATED_GROUPS)
HEADS_PER_GROUP = 4
ATT_QKV = N_DIL * HEADS_PER_GROUP * HEAD_DIM
ATT_OUT = HEADS_PER_GROUP * HEAD_DIM
CONV_DIM = D_MODEL - ATT_OUT
CONV_WIDTH = 31
D_IN = 3 * ATT_QKV + 2 * CONV_DIM
D_FF = 4 * D_MODEL
ROT_DIM = HEAD_DIM // 4
ROPE_THETA = 500000.0
BLK = 128
ATT_SCALE = HEAD_DIM ** -0.5
RMS_EPS = 1e-6
LN_EPS = 1e-5
NEG_INF = -1e30

kernel_name = "hybrid_dilated_attn_conformer_decoder_step"


def rms_norm(x, g):
    xf = x.astype(jnp.float32)
    y = xf * lax.rsqrt(jnp.mean(xf * xf, axis=-1, keepdims=True) + RMS_EPS)
    return (y * g.astype(jnp.float32)).astype(x.dtype)


def partial_rotary(x, pos):
    half = ROT_DIM // 2
    inv = 1.0 / (ROPE_THETA ** (jnp.arange(0, ROT_DIM, 2, dtype=jnp.float32) / ROT_DIM))
    ang = pos.astype(jnp.float32)[:, None] * inv[None, :]
    bshape = (ang.shape[0],) + (1,) * (x.ndim - 3) + (half,)
    cos = jnp.cos(ang).reshape(bshape)
    sin = jnp.sin(ang).reshape(bshape)
    xr = x[..., :ROT_DIM].astype(jnp.float32)
    x1, x2 = xr[..., :half], xr[..., half:]
    rot = jnp.concatenate([x1 * cos - x2 * sin, x2 * cos + x1 * sin], axis=-1)
    return jnp.concatenate([rot.astype(x.dtype), x[..., ROT_DIM:]], axis=-1)


def dilated_attn_prompt(q, k, v, dil, steps):
    b, s, h, dh = q.shape
    span = dil * BLK
    s_pad = -(-s // span) * span
    length = s_pad // dil
    nb = length // BLK

    def to_sub(t):
        t = jnp.pad(t, ((0, 0), (0, s_pad - s), (0, 0), (0, 0)))
        t = t.reshape(b, length, dil, h, dh).transpose(0, 2, 1, 3, 4)
        return t.reshape(b, dil, nb, BLK, h, dh)

    def with_prev(t):
        prev = jnp.pad(t[:, :, :-1], ((0, 0), (0, 0), (1, 0), (0, 0), (0, 0), (0, 0)))
        return jnp.concatenate([prev, t], axis=3)

    qs = to_sub(q)
    ks = with_prev(to_sub(k))
    vs = with_prev(to_sub(v))
    sc = jnp.einsum('brnqhd,brnkhd->brnhqk', qs, ks, preferred_element_type=jnp.float32) * ATT_SCALE
    qi = jnp.arange(BLK)[:, None]
    kj = jnp.arange(2 * BLK)[None, :] - BLK
    dist = qi - kj
    band = (dist >= 0) & (dist <= steps)
    has_prev = (jnp.arange(nb) > 0)[:, None, None] | (kj >= 0)[None]
    mask = band[None] & has_prev
    sc = jnp.where(mask[None, None, :, None], sc, NEG_INF)
    m = jnp.max(sc, axis=-1, keepdims=True)
    p = jnp.exp(sc - m)
    l = jnp.sum(p, axis=-1, keepdims=True)
    o = jnp.einsum('brnhqk,brnkhd->brnqhd', p, vs.astype(jnp.float32)) / jnp.moveaxis(l, 3, 4)
    lse = jnp.moveaxis((m + jnp.log(l))[..., 0], 3, 4)

    def from_sub(t):
        t = t.reshape(b, dil, length, *t.shape[4:])
        return jnp.moveaxis(t, 1, 2).reshape(b, s_pad, *t.shape[3:])[:, :s]

    return from_sub(o), from_sub(lse)


def dilated_attn_sample(q, kc, vc, n_buf, dil, steps):
    t = q.shape[1]
    idx = n_buf + jnp.arange(t)[:, None] - dil * jnp.arange(steps + 1)[None, :]
    valid = idx >= 0
    idx = jnp.maximum(idx, 0)
    kg = kc[:, idx]
    vg = vc[:, idx]
    sc = jnp.einsum('bthd,btjhd->bhtj', q, kg, preferred_element_type=jnp.float32) * ATT_SCALE
    sc = jnp.where(valid[None, None], sc, NEG_INF)
    m = jnp.max(sc, axis=-1, keepdims=True)
    p = jnp.exp(sc - m)
    l = jnp.sum(p, axis=-1, keepdims=True)
    o = jnp.einsum('bhtj,btjhd->bthd', p, vg.astype(jnp.float32)) / jnp.moveaxis(l, 1, 2)
    lse = jnp.moveaxis((m + jnp.log(l))[..., 0], 1, 2)
    return o, lse


def hybrid_layer(x, pos, kv_bufs, conv_buf, w_in, w_o, conv_w, conv_b, ln_g, ln_b, g_mix, g_ffn, w_up, w_down):
    b, s, _ = x.shape
    n = rms_norm(x, g_mix)
    z = jnp.einsum('bsd,de->bse', n, w_in)
    q, k, v, glu = jnp.split(z, [ATT_QKV, 2 * ATT_QKV, 3 * ATT_QKV], axis=-1)
    shp = (b, s, N_DIL, HEADS_PER_GROUP, HEAD_DIM)
    q = partial_rotary(q.reshape(shp), pos)
    k = partial_rotary(k.reshape(shp), pos)
    v = v.reshape(shp)

    outs, lses, new_kv = [], [], []
    for g, (win, dil) in enumerate(DILATED_GROUPS):
        qg, kg, vg = q[:, :, g], k[:, :, g], v[:, :, g]
        steps = win // dil
        if kv_bufs is None:
            o, lse = dilated_attn_prompt(qg, kg, vg, dil, steps)
            keep = min(win, s)
            new_kv.append(jnp.stack([kg[:, s - keep:], vg[:, s - keep:]], axis=1))
        else:
            buf = kv_bufs[g]
            n_buf = buf.shape[2]
            kc = jnp.concatenate([buf[:, 0].astype(kg.dtype), kg], axis=1)
            vc = jnp.concatenate([buf[:, 1].astype(vg.dtype), vg], axis=1)
            o, lse = dilated_attn_sample(qg, kc, vc, n_buf, dil, steps)
            new_kv.append(jnp.stack([kc[:, -n_buf:], vc[:, -n_buf:]], axis=1))
        outs.append(o)
        lses.append(lse)
    wts = jax.nn.softmax(jnp.stack(lses, axis=0), axis=0)
    att = jnp.sum(wts[..., None] * jnp.stack(outs, axis=0), axis=0)
    att = att.reshape(b, s, ATT_OUT).astype(x.dtype)

    a, gate = jnp.split(glu, 2, axis=-1)
    u = a * jax.nn.sigmoid(gate)
    if conv_buf is None:
        uc = jnp.pad(u, ((0, 0), (CONV_WIDTH - 1, 0), (0, 0)))
    else:
        uc = jnp.concatenate([conv_buf.astype(u.dtype), u], axis=1)
    new_conv = uc[:, -(CONV_WIDTH - 1):]
    c = lax.conv_general_dilated(uc, conv_w[:, None, :].astype(uc.dtype), window_strides=(1,), padding='VALID',
                                 dimension_numbers=('NWC', 'WIO', 'NWC'), feature_group_count=CONV_DIM)
    cf = c.astype(jnp.float32) + conv_b.astype(jnp.float32)
    mu = jnp.mean(cf, axis=-1, keepdims=True)
    var = jnp.mean(jnp.square(cf - mu), axis=-1, keepdims=True)
    cf = (cf - mu) * lax.rsqrt(var + LN_EPS) * ln_g.astype(jnp.float32) + ln_b.astype(jnp.float32)
    cv = (cf * jax.nn.sigmoid(cf)).astype(x.dtype)

    h = x + jnp.einsum('bse,ed->bsd', jnp.concatenate([att, cv], axis=-1), w_o)
    n2 = rms_norm(h, g_ffn)
    f = jnp.square(jax.nn.relu(jnp.einsum('bsd,df->bsf', n2, w_up)))
    y = h + jnp.einsum('bsf,fd->bsd', f, w_down)
    return y, new_kv, new_conv


def setup_inputs(seed: int = 0) -> dict:
    key = jax.random.key(seed)
    ks = jax.random.split(key, 20)
    f32 = jnp.float32

    def nrm(k, shape, scale):
        return jax.random.normal(k, shape, f32) * scale

    def kv_shape(w):
        return (DEPTH, DEC_BATCH, 2, min(w, PAST_LEN), HEADS_PER_GROUP, HEAD_DIM)

    return {
        "x_prompt": nrm(ks[0], (BATCH, SEQ, D_MODEL), 1.0),
        "x_sample": nrm(ks[1], (DEC_BATCH, DEC_SEQ, D_MODEL), 1.0),
        "cache_kv_w128": nrm(ks[2], kv_shape(DILATED_GROUPS[0][0]), 1.0),
        "cache_kv_w512": nrm(ks[3], kv_shape(DILATED_GROUPS[1][0]), 1.0),
        "cache_kv_w2048": nrm(ks[4], kv_shape(DILATED_GROUPS[2][0]), 1.0),
        "state_conv": nrm(ks[5], (DEPTH, DEC_BATCH, CONV_WIDTH - 1, CONV_DIM), 0.5),
        "w_in": nrm(ks[6], (DEPTH, D_MODEL, D_IN), D_MODEL ** -0.5),
        "w_o": nrm(ks[7], (DEPTH, D_MODEL, D_MODEL), D_MODEL ** -0.5),
        "conv_w": nrm(ks[8], (DEPTH, CONV_WIDTH, CONV_DIM), CONV_WIDTH ** -0.5),
        "conv_b": nrm(ks[9], (DEPTH, CONV_DIM), 0.02),
        "conv_ln_g": 1.0 + nrm(ks[10], (DEPTH, CONV_DIM), 0.02),
        "conv_ln_b": nrm(ks[11], (DEPTH, CONV_DIM), 0.02),
        "norm_mix": 1.0 + nrm(ks[12], (DEPTH, D_MODEL), 0.02),
        "norm_ffn": 1.0 + nrm(ks[13], (DEPTH, D_MODEL), 0.02),
        "w_up": nrm(ks[14], (DEPTH, D_MODEL, D_FF), D_MODEL ** -0.5),
        "w_down": nrm(ks[15], (DEPTH, D_FF, D_MODEL), D_FF ** -0.5),
        "norm_final": 1.0 + nrm(ks[16], (D_MODEL,), 0.02),
    }


def reference(x_prompt, x_sample, cache_kv_w128, cache_kv_w512, cache_kv_w2048, state_conv,
              w_in, w_o, conv_w, conv_b, conv_ln_g, conv_ln_b, norm_mix, norm_ffn, w_up, w_down, norm_final):
    pos_p = jnp.arange(x_prompt.shape[1], dtype=jnp.int32)
    pos_s = PAST_LEN + jnp.arange(x_sample.shape[1], dtype=jnp.int32)
    caches = (cache_kv_w128, cache_kv_w512, cache_kv_w2048)
    hp, hs = x_prompt, x_sample
    kv_p = [[] for _ in range(N_DIL)]
    kv_s = [[] for _ in range(N_DIL)]
    conv_p, conv_s = [], []
    for l in range(DEPTH):
        params = (w_in[l], w_o[l], conv_w[l], conv_b[l], conv_ln_g[l], conv_ln_b[l],
                  norm_mix[l], norm_ffn[l], w_up[l], w_down[l])
        hp, nkv_p, ncv_p = hybrid_layer(hp, pos_p, None, None, *params)
        hs, nkv_s, ncv_s = hybrid_layer(hs, pos_s, [c[l] for c in caches], state_conv[l], *params)
        for g in range(N_DIL):
            kv_p[g].append(nkv_p[g])
            kv_s[g].append(nkv_s[g])
        conv_p.append(ncv_p)
        conv_s.append(ncv_s)
    y_prompt = rms_norm(hp, norm_final)
    y_sample = rms_norm(hs, norm_final)
    new_kv_w128_prompt = jnp.stack(kv_p[0])
    new_kv_w512_prompt = jnp.stack(kv_p[1])
    new_kv_w2048_prompt = jnp.stack(kv_p[2])
    new_conv_prompt = jnp.stack(conv_p)
    new_kv_w128_sample = jnp.stack(kv_s[0])
    new_kv_w512_sample = jnp.stack(kv_s[1])
    new_kv_w2048_sample = jnp.stack(kv_s[2])
    new_conv_sample = jnp.stack(conv_s)
    return (y_prompt, y_sample, new_kv_w128_prompt, new_kv_w512_prompt, new_kv_w2048_prompt, new_conv_prompt,
            new_kv_w128_sample, new_kv_w512_sample, new_kv_w2048_sample, new_conv_sample)
```

```cpp
#include <hip/hip_runtime.h>
#include <hip/hip_cooperative_groups.h>
#include <cstdio>
#include <cstdint>
#include <cmath>
namespace cg = cooperative_groups;

namespace cfg {
constexpr int D = 1024, SEQ = 8192, NB = 4, MP = NB * SEQ, DEPTH = 2, SB = 32, PAST = 16384;
constexpr int DIN = 3840, DFF = 4096, CONV = 768, CW = 31;
constexpr float C2 = 0.125f * 1.4426950408889634f;
constexpr size_t O_YP = 0, O_YS = 33554432, O_KP0 = 33587200, O_KP1 = 34111488, O_KP2 = 36208640, O_CP = 44597248,
                 O_KS0 = 44781568, O_KS1 = 48975872, O_KS2 = 65753088, O_CS = 132861952, O_END = 134336512;
}
namespace pg8 {
#define PG8_LAS __attribute__((address_space(3)))
typedef unsigned short bf16_t;
typedef short bf16x8 __attribute__((ext_vector_type(8)));
typedef float f32x4 __attribute__((ext_vector_type(4)));
typedef unsigned u32x4 __attribute__((ext_vector_type(4)));
constexpr int BM = 256, BK = 64, HALF = 128, HTB = HALF * BK * 2  , STAGE_BYTES = 8 * HTB, NXCD = 8, WGM = 8;

__host__ __device__ __forceinline__ int lds_byte(int r, int c) { const int st = (r >> 4) * 2 + (c >> 5), rr = r & 15, cc = c & 31, ob = rr * 64 + cc * 2; return st * 1024 + (ob ^ (((ob >> 9) & 1) << 5)); }
__host__ __device__ __forceinline__ void stage_rc(int b, int& R, int& C) { const int st = b / 1024, sb = b % 1024, swz = sb ^ (((sb >> 9) & 1) << 5); R = (st >> 1) * 16 + swz / 64; C = (st & 1) * 32 + (swz % 64) / 2; }
__host__ __device__ __forceinline__ int perm32(int rho) { const int n = rho >> 4, i = rho & 15; return 8 * (i >> 2) + 4 * n + (i & 3); }

struct Unit { int pm, pn; };
struct Gemm { const bf16_t* A; const bf16_t* Bt; int M, N, K; };

struct StaticOrder {
    int nM, nN, nwg, G, c;
    __host__ __device__ void init(int M, int N, int G_, int c_) { nM = M / BM; nN = N / BM; nwg = nM * nN; G = G_; c = c_; }
    __host__ __device__ bool next(int i, Unit& u) const {
        const long L = (long)i * G + c; if (L >= nwg) return false;
        int wgid = (int)L; { const int q = nwg / NXCD, r = nwg % NXCD, xcd = wgid % NXCD, off = wgid / NXCD; wgid = (xcd < r ? xcd * (q + 1) : r * (q + 1) + (xcd - r) * q) + off; }
        const int nig = WGM * nN, gid = wgid / nig, fm = gid * WGM, gsz = (nM - fm) < WGM ? (nM - fm) : WGM;
        u.pm = fm + ((wgid % nig) % gsz); u.pn = (wgid % nig) / gsz; return true;
    }
    __device__ __forceinline__ void a_ready(const Unit&) const {}
    __device__ __forceinline__ void done(const Unit&) const {}
};

__device__ __forceinline__ unsigned cvt_pk_bf16(float lo, float hi) { unsigned r; asm volatile("v_cvt_pk_bf16_f32 %0, %1, %2" : "=v"(r) : "v"(lo), "v"(hi)); return r; }
typedef float f32x2 __attribute__((ext_vector_type(2)));
typedef unsigned u32x2 __attribute__((ext_vector_type(2)));
__device__ __forceinline__ float row_rs(const float* ssq, int row) {
    const f32x4* sp = (const f32x4*)(ssq + (size_t)row * 16);
    const f32x4 st = (sp[0] + sp[1]) + (sp[2] + sp[3]);
    return rsqrtf(((st[0] + st[1]) + (st[2] + st[3])) * (1.f / 1024.f) + 1e-6f);
}
__device__ __forceinline__ float row_rs4(const float* ssq, int row, int fq) {
    const f32x4 p = *(const f32x4*)(ssq + (size_t)row * 16 + fq * 4);
    float s = (p[0] + p[1]) + (p[2] + p[3]); s += __shfl_xor(s, 16); s += __shfl_xor(s, 32);
    return rsqrtf(s * (1.f / 1024.f) + 1e-6f);
}
struct EpiIn {
    static constexpr bool PERM = true, AFTER_DRAIN = false, HAS_RS = true;
    const float* ssq; const float* cs; bf16_t* Q; size_t kstride; bf16_t* Ub;
    __device__ __forceinline__ void fetch_rs(float (&rsv)[2][4], const Unit& u, int wr, int fr, int fq) const {
#pragma unroll
        for (int ai = 0; ai < 2; ++ai)
#pragma unroll
            for (int m = 0; m < 4; ++m) rsv[ai][m] = row_rs4(ssq, u.pm * BM + wr * 64 + fr + ai * HALF + m * 16, fq);
    }
    __device__ __forceinline__ void operator()(const f32x4 (&acc)[2][2][4][2], const Unit& u, int wr, int wc, int fr, int fq, float (&rsv)[2][4], bool has_next, const Unit& nxt) const {
        const int pn = u.pn;
        const int row0 = u.pm * BM + wr * 64 + fr;
        const int cw = wc * 32 + 8 * fq;
#pragma unroll
        for (int ai = 0; ai < 2; ++ai)
#pragma unroll
            for (int m = 0; m < 4; ++m) {
                const int row = row0 + ai * HALF + m * 16;
                const float rs = rsv[ai][m];
                const int s = row & 8191;
                if (pn < 9) {
                    const int kind = pn / 3, g = pn - kind * 3;
                    bf16_t* dst = Q + (size_t)kind * kstride;
                    const float qs = kind == 0 ? cfg::C2 : 1.f;
                    const bool rot = (kind < 2) && ((wc & 1) == 0);
                    f32x4 cA = {1.f, 1.f, 1.f, 1.f}, cB = cA, sA = {0.f, 0.f, 0.f, 0.f}, sB = sA;
                    if (rot) { const f32x4* cp = (const f32x4*)(cs + (size_t)s * 16); cA = cp[0]; cB = cp[1]; sA = cp[2]; sB = cp[3]; }
#pragma unroll
                    for (int bj = 0; bj < 2; ++bj) {
                        f32x4 v0 = acc[ai][bj][m][0] * rs, v1 = acc[ai][bj][m][1] * rs;
                        if (rot) {
                            f32x4 o0, o1;
#pragma unroll
                            for (int i = 0; i < 4; ++i) { o0[i] = __shfl_xor(v0[i], 16); o1[i] = __shfl_xor(v1[i], 16); }
                            if (fq < 2) { const float sg = fq == 0 ? -1.f : 1.f; v0 = v0 * cA + (o0 * sA) * sg; v1 = v1 * cB + (o1 * sB) * sg; }
                        }
                        const int col = g * 256 + bj * HALF + cw;
                        v0 = v0 * qs; v1 = v1 * qs;
                        u32x4 w; w.x = cvt_pk_bf16(v0[0], v0[1]); w.y = cvt_pk_bf16(v0[2], v0[3]); w.z = cvt_pk_bf16(v1[0], v1[1]); w.w = cvt_pk_bf16(v1[2], v1[3]);
                        *(u32x4*)(dst + (size_t)row * 768 + col) = w;
                    }
                } else {
                    const int ch = (pn - 9) * 128 + cw;
                    const f32x4 a0 = acc[ai][0][m][0] * rs, a1 = acc[ai][0][m][1] * rs, g0 = acc[ai][1][m][0] * rs, g1 = acc[ai][1][m][1] * rs;
                    f32x4 u0, u1;
#pragma unroll
                    for (int i = 0; i < 4; ++i) { u0[i] = a0[i] * __builtin_amdgcn_rcpf(1.f + __expf(-g0[i])); u1[i] = a1[i] * __builtin_amdgcn_rcpf(1.f + __expf(-g1[i])); }
                    u32x4 w; w.x = cvt_pk_bf16(u0[0], u0[1]); w.y = cvt_pk_bf16(u0[2], u0[3]); w.z = cvt_pk_bf16(u1[0], u1[1]); w.w = cvt_pk_bf16(u1[2], u1[3]);
                    *(u32x4*)(Ub + (size_t)row * 768 + ch) = w;
                }
            }
        if (has_next) fetch_rs(rsv, nxt, wr, fr, fq);
    }
};
struct EpiRes {
    static constexpr bool PERM = true, AFTER_DRAIN = false, HAS_RS = false;
    bf16_t* xb; float* ssq;
    __device__ __forceinline__ void operator()(const f32x4 (&acc)[2][2][4][2], const Unit& u, int wr, int wc, int fr, int fq) const {
        const int row0 = u.pm * BM + wr * 64 + fr, col0 = u.pn * BM + wc * 32 + 8 * fq;
#pragma unroll
        for (int ai = 0; ai < 2; ++ai) {
            u32x4 bw[4][2];
#pragma unroll
            for (int m = 0; m < 4; ++m)
#pragma unroll
                for (int bj = 0; bj < 2; ++bj) bw[m][bj] = *(const u32x4*)(xb + (size_t)(row0 + ai * HALF + m * 16) * 1024 + col0 + bj * HALF);
#pragma unroll
            for (int m = 0; m < 4; ++m) {
                const int row = row0 + ai * HALF + m * 16; const size_t off = (size_t)row * 1024 + col0; float q = 0.f;
#pragma unroll
                for (int bj = 0; bj < 2; ++bj) {
                    const u32x4 b4 = bw[m][bj];
                    f32x4 o0 = acc[ai][bj][m][0], o1 = acc[ai][bj][m][1];
                    o0[0] += __uint_as_float(b4.x << 16); o0[1] += __uint_as_float(b4.x & 0xffff0000u); o0[2] += __uint_as_float(b4.y << 16); o0[3] += __uint_as_float(b4.y & 0xffff0000u);
                    o1[0] += __uint_as_float(b4.z << 16); o1[1] += __uint_as_float(b4.z & 0xffff0000u); o1[2] += __uint_as_float(b4.w << 16); o1[3] += __uint_as_float(b4.w & 0xffff0000u);
                    { u32x4 w; w.x = cvt_pk_bf16(o0[0], o0[1]); w.y = cvt_pk_bf16(o0[2], o0[3]); w.z = cvt_pk_bf16(o1[0], o1[1]); w.w = cvt_pk_bf16(o1[2], o1[3]); *(u32x4*)(xb + off + bj * HALF) = w; }
                    q += ((o0[0] * o0[0] + o0[1] * o0[1]) + (o0[2] * o0[2] + o0[3] * o0[3])) + ((o1[0] * o1[0] + o1[1] * o1[1]) + (o1[2] * o1[2] + o1[3] * o1[3]));
                }
                q += __shfl_xor(q, 16); q += __shfl_xor(q, 32);
                if (fq == 0) ssq[(size_t)row * 16 + u.pn * 4 + wc] = q;
            }
        }
    }
};
struct EpiUp {
    static constexpr bool PERM = true, AFTER_DRAIN = false, HAS_RS = true;
    const float* ssq; bf16_t* F;
    __device__ __forceinline__ void fetch_rs(float (&rsv)[2][4], const Unit& u, int wr, int fr, int fq) const {
#pragma unroll
        for (int ai = 0; ai < 2; ++ai)
#pragma unroll
            for (int m = 0; m < 4; ++m) rsv[ai][m] = row_rs4(ssq, u.pm * BM + wr * 64 + fr + ai * HALF + m * 16, fq);
    }
    __device__ __forceinline__ void operator()(const f32x4 (&acc)[2][2][4][2], const Unit& u, int wr, int wc, int fr, int fq, float (&rsv)[2][4], bool has_next, const Unit& nxt) const {
        const int row0 = u.pm * BM + wr * 64 + fr, col0 = u.pn * BM + wc * 32 + 8 * fq;
#pragma unroll
        for (int ai = 0; ai < 2; ++ai)
#pragma unroll
            for (int m = 0; m < 4; ++m) {
                const int row = row0 + ai * HALF + m * 16; const float rs = rsv[ai][m];
#pragma unroll
                for (int bj = 0; bj < 2; ++bj) {
                    f32x4 v0 = acc[ai][bj][m][0] * rs, v1 = acc[ai][bj][m][1] * rs;
#pragma unroll
                    for (int i = 0; i < 4; ++i) { const float a = fmaxf(v0[i], 0.f), c = fmaxf(v1[i], 0.f); v0[i] = a * a; v1[i] = c * c; }
                    u32x4 w; w.x = cvt_pk_bf16(v0[0], v0[1]); w.y = cvt_pk_bf16(v0[2], v0[3]); w.z = cvt_pk_bf16(v1[0], v1[1]); w.w = cvt_pk_bf16(v1[2], v1[3]);
                    *(u32x4*)(F + (size_t)row * 4096 + col0 + bj * HALF) = w;
                }
            }
        if (has_next) fetch_rs(rsv, nxt, wr, fr, fq);
    }
};

template <class Epi, class Sched, bool ALIGN_EPI = false, bool SP2 = false>
__device__ __forceinline__ void gemm_phase(PG8_LAS unsigned char* lds, const Gemm g, const Sched& S, const Epi& E) {
    int tid_ = threadIdx.x; asm volatile("" : "+v"(tid_));
    const int tid = tid_, wid = __builtin_amdgcn_readfirstlane(tid >> 6), lane = tid & 63, wr = wid >> 2, wc = wid & 3, fr = lane & 15, fq = lane >> 4;
    const int K = g.K, nt = K / BK;
    unsigned voffA[2], voffB[2];
#pragma unroll
    for (int i = 0; i < 2; ++i) { int R, C; stage_rc(tid * 16 + i * 8192, R, C); const int Rb = Epi::PERM ? ((R & ~31) + perm32(R & 31)) : R;
        voffA[i] = (unsigned)(R * K + C) * 2u; voffB[i] = (unsigned)(Rb * K + C) * 2u; }
    const size_t kstep = (size_t)(BK * 2);
    const size_t hstep = (size_t)HALF * K * 2;
    const size_t tstep = 2 * hstep;
    const unsigned ldsw = (unsigned)wid * 1024u;
    const int aoff = lds_byte(wr * 64 + fr, fq * 8), boff = lds_byte(wc * 32 + fr, fq * 8);
#define PG8_SA(b, h) (((b) * 2 + (h)) * HTB)
#define PG8_SB(b, h) ((4 + (b) * 2 + (h)) * HTB)
#define PG8_STAGE(bufoff, gbase, voff) do { _Pragma("unroll") for (int _i = 0; _i < 2; ++_i) \
        __builtin_amdgcn_global_load_lds((const unsigned*)((const char*)(gbase) + (voff)[_i]), (PG8_LAS unsigned*)(lds + (bufoff) + ldsw + _i * 8192), 16, 0, 0); } while (0)
#define PG8_LDA(dst, b, h) do { _Pragma("unroll") for (int m = 0; m < 4; ++m) _Pragma("unroll") for (int k = 0; k < 2; ++k) dst[m][k] = *(const PG8_LAS bf16x8*)(lds + PG8_SA(b, h) + aoff + m * 2048 + k * 1024); } while (0)
#define PG8_LDB(dst, b, h) do { _Pragma("unroll") for (int n = 0; n < 2; ++n) _Pragma("unroll") for (int k = 0; k < 2; ++k) dst[n][k] = *(const PG8_LAS bf16x8*)(lds + PG8_SB(b, h) + boff + n * 2048 + k * 1024); } while (0)
#define PG8_MMA(ai, bj, At, Bt) do { __builtin_amdgcn_s_setprio(1); _Pragma("unroll") for (int m = 0; m < 4; ++m) _Pragma("unroll") for (int n = 0; n < 2; ++n) _Pragma("unroll") for (int k = 0; k < 2; ++k) \
        acc[ai][bj][m][n] = __builtin_amdgcn_mfma_f32_16x16x32_bf16(Bt[n][k], At[m][k], acc[ai][bj][m][n], 0, 0, 0); __builtin_amdgcn_s_setprio(0); } while (0)
#define PG8_WAIT_V(n) asm volatile("s_waitcnt vmcnt(" #n ")" ::: "memory")
#define PG8_WAIT_L(n) asm volatile("s_waitcnt lgkmcnt(" #n ")" ::: "memory")
#define PG8_BAR __builtin_amdgcn_s_barrier()
#define PG8_SCHED __builtin_amdgcn_sched_barrier(0)
    Unit cur, nxt; int ui = 0;
    if (!S.next(0, cur)) return;
    f32x4 acc[2][2][4][2];
    float rsv[2][4];
    if constexpr (Epi::HAS_RS) E.fetch_rs(rsv, cur, wr, fr, fq);
#pragma unroll
    for (int a = 0; a < 2; ++a)
#pragma unroll
        for (int b = 0; b < 2; ++b)
#pragma unroll
            for (int m = 0; m < 4; ++m)
#pragma unroll
                for (int n = 0; n < 2; ++n) acc[a][b][m][n] = (f32x4){0.f, 0.f, 0.f, 0.f};
    bf16x8 At[4][2], B0[2][2], B1[2][2];
    const char* cA = (const char*)g.A + (size_t)cur.pm * tstep; const char* cB = (const char*)g.Bt + (size_t)cur.pn * tstep;
    S.a_ready(cur);
    if constexpr (SP2) {
        PG8_STAGE(PG8_SB(0, 0), cB, voffB); PG8_STAGE(PG8_SB(0, 1), cB + hstep, voffB); PG8_STAGE(PG8_SA(0, 0), cA, voffA); PG8_STAGE(PG8_SA(0, 1), cA + hstep, voffA);
        if (wr == 1) PG8_BAR;
        PG8_WAIT_V(2); PG8_BAR;
        PG8_STAGE(PG8_SB(1, 0), cB + kstep, voffB); PG8_STAGE(PG8_SA(1, 0), cA + kstep, voffA); PG8_STAGE(PG8_SB(1, 1), cB + hstep + kstep, voffB);
        PG8_WAIT_V(6); PG8_BAR;
    } else {
        PG8_STAGE(PG8_SB(0, 0), cB, voffB); PG8_STAGE(PG8_SA(0, 0), cA, voffA); PG8_STAGE(PG8_SB(0, 1), cB + hstep, voffB); PG8_STAGE(PG8_SA(0, 1), cA + hstep, voffA);
        if (wr == 1) PG8_BAR;
        PG8_WAIT_V(4); PG8_BAR;
        PG8_STAGE(PG8_SB(1, 0), cB + kstep, voffB); PG8_STAGE(PG8_SA(1, 0), cA + kstep, voffA); PG8_STAGE(PG8_SB(1, 1), cB + hstep + kstep, voffB);
        PG8_WAIT_V(6); PG8_BAR;
    }
    for (;;) {
        const bool has_next = S.next(ui + 1, nxt);
        const char* nA = has_next ? (const char*)g.A + (size_t)nxt.pm * tstep : cA; const char* nB = has_next ? (const char*)g.Bt + (size_t)nxt.pn * tstep : cB;
        for (int t = 0; t < nt; t += 2) {
            const bool last = (t == nt - 2);
            const char* a1 = cA + (size_t)(t + 1) * kstep;
            const char* a2 = last ? nA : cA + (size_t)(t + 2) * kstep; const char* b2 = last ? nB : cB + (size_t)(t + 2) * kstep;
            const char* a3 = a2 + kstep; const char* b3 = b2 + kstep;
            if (last && has_next) S.a_ready(nxt);
            if constexpr (SP2) {
            PG8_LDB(B0, 0, 0); PG8_LDB(B1, 0, 1); PG8_SCHED; PG8_LDA(At, 0, 0); PG8_STAGE(PG8_SA(1, 1), a1 + hstep, voffA);
            PG8_WAIT_V(8); PG8_WAIT_L(0); PG8_BAR; PG8_MMA(0, 0, At, B0); PG8_MMA(0, 1, At, B1); PG8_BAR; PG8_SCHED;
            PG8_LDA(At, 0, 1); PG8_STAGE(PG8_SB(0, 0), b2, voffB); PG8_STAGE(PG8_SB(0, 1), b2 + hstep, voffB); PG8_STAGE(PG8_SA(0, 0), a2, voffA);
            PG8_WAIT_V(8); PG8_WAIT_L(0); PG8_BAR; PG8_MMA(1, 0, At, B0); PG8_MMA(1, 1, At, B1); PG8_BAR; PG8_SCHED;
            PG8_LDB(B0, 1, 0); PG8_LDB(B1, 1, 1); PG8_SCHED; PG8_LDA(At, 1, 0); PG8_STAGE(PG8_SA(0, 1), a2 + hstep, voffA);
            PG8_WAIT_V(8); PG8_WAIT_L(0); PG8_BAR; PG8_MMA(0, 0, At, B0); PG8_MMA(0, 1, At, B1); PG8_BAR; PG8_SCHED;
            PG8_LDA(At, 1, 1); PG8_STAGE(PG8_SB(1, 0), b3, voffB); PG8_STAGE(PG8_SB(1, 1), b3 + hstep, voffB); PG8_STAGE(PG8_SA(1, 0), a3, voffA);
            PG8_WAIT_V(8); PG8_WAIT_L(0); PG8_BAR; PG8_MMA(1, 0, At, B0); PG8_MMA(1, 1, At, B1); PG8_BAR; PG8_SCHED;
            } else {
            PG8_LDB(B0, 0, 0); PG8_SCHED; PG8_LDA(At, 0, 0); PG8_STAGE(PG8_SA(1, 1), a1 + hstep, voffA);
            PG8_WAIT_L(8); PG8_BAR; PG8_WAIT_L(0); PG8_MMA(0, 0, At, B0); PG8_BAR; PG8_SCHED;
            PG8_LDB(B1, 0, 1); PG8_STAGE(PG8_SB(0, 0), b2, voffB);
            PG8_BAR; PG8_WAIT_L(0); PG8_MMA(0, 1, At, B1); PG8_BAR;
            PG8_LDA(At, 0, 1); PG8_STAGE(PG8_SA(0, 0), a2, voffA);
            PG8_BAR; PG8_WAIT_L(0); PG8_MMA(1, 0, At, B0); PG8_BAR; PG8_SCHED;
            PG8_STAGE(PG8_SB(0, 1), b2 + hstep, voffB);
            PG8_WAIT_V(6); PG8_BAR; PG8_MMA(1, 1, At, B1); PG8_BAR;
            PG8_LDB(B0, 1, 0); PG8_SCHED; PG8_LDA(At, 1, 0); PG8_STAGE(PG8_SA(0, 1), a2 + hstep, voffA);
            PG8_WAIT_L(8); PG8_BAR; PG8_WAIT_L(0); PG8_MMA(0, 0, At, B0); PG8_BAR; PG8_SCHED;
            PG8_LDB(B1, 1, 1); PG8_STAGE(PG8_SB(1, 0), b3, voffB);
            PG8_BAR; PG8_WAIT_L(0); PG8_MMA(0, 1, At, B1); PG8_BAR;
            PG8_LDA(At, 1, 1); PG8_STAGE(PG8_SA(1, 0), a3, voffA);
            PG8_BAR; PG8_WAIT_L(0); PG8_MMA(1, 0, At, B0); PG8_BAR; PG8_SCHED;
            PG8_STAGE(PG8_SB(1, 1), b3 + hstep, voffB);
            PG8_WAIT_V(6); PG8_BAR; PG8_MMA(1, 1, At, B1); PG8_BAR;
            }
        }
        if constexpr (ALIGN_EPI) { if (wr == 0) PG8_BAR; }
        if constexpr (Epi::HAS_RS) { E(acc, cur, wr, wc, fr, fq, rsv, has_next, nxt); S.done(cur); }
        else if constexpr (!Epi::AFTER_DRAIN) { E(acc, cur, wr, wc, fr, fq); S.done(cur); }
        if (!has_next) break;
#pragma unroll
        for (int a = 0; a < 2; ++a)
#pragma unroll
            for (int b = 0; b < 2; ++b)
#pragma unroll
                for (int m = 0; m < 4; ++m)
#pragma unroll
                    for (int n = 0; n < 2; ++n) acc[a][b][m][n] = (f32x4){0.f, 0.f, 0.f, 0.f};
        cur = nxt; cA = nA; cB = nB; ++ui;
        if constexpr (ALIGN_EPI) { if (wr == 1) PG8_BAR; }
    }
    PG8_WAIT_V(0);
    if constexpr (!ALIGN_EPI) { if (wr == 0) PG8_BAR; }
    PG8_BAR;
    if constexpr (Epi::AFTER_DRAIN) { E.fused(acc, cur, wr, wc, fr, fq, lds, wid, lane); S.done(cur); }
#undef PG8_SA
#undef PG8_SB
#undef PG8_STAGE
#undef PG8_LDA
#undef PG8_LDB
#undef PG8_MMA
#undef PG8_WAIT_V
#undef PG8_WAIT_L
#undef PG8_BAR
#undef PG8_SCHED
}
}

#define LAS __attribute__((address_space(3)))
typedef unsigned short bf16;
typedef float f32x4 __attribute__((ext_vector_type(4)));
typedef float f32x16 __attribute__((ext_vector_type(16)));
typedef short bf16x8 __attribute__((ext_vector_type(8)));
typedef short s16x4 __attribute__((ext_vector_type(4)));
typedef unsigned u32x4 __attribute__((ext_vector_type(4)));
typedef unsigned u32x2 __attribute__((ext_vector_type(2)));
using namespace cfg;
constexpr size_t MiB = 1u << 20;
constexpr size_t WS_W = 2 * MiB, W_LSTRIDE = 26 * MiB, W_IN = 0, W_O = 8 * MiB, W_UP = 10 * MiB, W_DN = 18 * MiB;
constexpr size_t WS_CS = 54 * MiB, WS_SSQ = 55 * MiB, WS_LSE = 57 * MiB, WS_SMALL = 59 * MiB;
constexpr size_t WS_XB = 64 * MiB, WS_R = 128 * MiB, WS_Q = 256 * MiB, WS_K = 304 * MiB, WS_V = 352 * MiB, WS_U = 400 * MiB, WS_CAT = 448 * MiB, WS_F = 256 * MiB, WS_OG = 512 * MiB, WS_END = 560 * MiB;
constexpr size_t SM_XS = 0, SM_XSB = 131072, SM_ZS = 196608, SM_SSQS = 688128, SM_OGS = 696320, SM_LSES = 794624, SM_CATS = 798720, SM_FS = 864256, SM_CVS = 1126400, SM_END = 1224704;
constexpr int LDS_BYTES = 163840;

#define WS_DPP(v, ctrl) __uint_as_float((unsigned)__builtin_amdgcn_update_dpp(0, (int)__float_as_uint(v), (ctrl), 0xf, 0xf, true))
__device__ __forceinline__ float wave_sum(float v) {
    v += WS_DPP(v, 0xB1);
    v += WS_DPP(v, 0x4E);
    v += WS_DPP(v, 0x141);
    v += WS_DPP(v, 0x140);
    v += __shfl_xor(v, 16);
    const auto rr = __builtin_amdgcn_permlane32_swap(__float_as_uint(v), __float_as_uint(v), false, false);
    return __uint_as_float(rr[0]) + __uint_as_float(rr[1]);
}
__device__ __forceinline__ float wave_max(float v) {
#pragma unroll
    for (int o = 1; o < 64; o <<= 1) v = fmaxf(v, __shfl_xor(v, o));
    return v;
}
__device__ __forceinline__ unsigned pk2(float lo, float hi) { return pg8::cvt_pk_bf16(lo, hi); }
__device__ __forceinline__ float bflo(unsigned x) { return __uint_as_float(x << 16); }
__device__ __forceinline__ float bfhi(unsigned x) { return __uint_as_float(x & 0xffff0000u); }
__device__ __forceinline__ f32x4 ld4bf(const bf16* p) { const u32x2 w = *(const u32x2*)p; return (f32x4){bflo(w.x), bfhi(w.x), bflo(w.y), bfhi(w.y)}; }
__device__ __forceinline__ void st4bf(bf16* p, f32x4 v) { u32x2 w; w.x = pk2(v[0], v[1]); w.y = pk2(v[2], v[3]); *(u32x2*)p = w; }

__device__ __forceinline__ void p0_transpose_item(const float* W, int K, int N, int srccol0, const float* gain, bf16* WT, int drow0, LAS float* scr, int k0, int lane) {
    f32x4 wv[8];
#pragma unroll
    for (int i = 0; i < 8; ++i) { const int kk = 8 * i + (lane >> 3); wv[i] = __builtin_nontemporal_load((const f32x4*)(W + (size_t)(k0 + kk) * N + srccol0 + 4 * (lane & 7))); if (gain) wv[i] = wv[i] * gain[k0 + kk]; }
#pragma unroll
    for (int i = 0; i < 8; ++i) { const int kk = 8 * i + (lane >> 3); LAS float* d = scr + kk * 33 + 4 * (lane & 7); d[0] = wv[i][0]; d[1] = wv[i][1]; d[2] = wv[i][2]; d[3] = wv[i][3]; }
    asm volatile("s_waitcnt lgkmcnt(0)" ::: "memory");
    const int c = lane & 7;
#pragma unroll
    for (int j = 0; j < 4; ++j) { const int n = (lane >> 3) + 8 * j; const LAS float* s = scr + (8 * c) * 33 + n;
        u32x4 o; o.x = pk2(s[0 * 33], s[1 * 33]); o.y = pk2(s[2 * 33], s[3 * 33]); o.z = pk2(s[4 * 33], s[5 * 33]); o.w = pk2(s[6 * 33], s[7 * 33]);
        *(u32x4*)(WT + (size_t)(drow0 + n) * K + k0 + 8 * c) = o; }
    asm volatile("s_waitcnt lgkmcnt(0)" ::: "memory");
}
__device__ __forceinline__ int win_srccol(int n) {
    if (n < 2304) return n;
    const int t = (n - 2304) >> 8, w = (n - 2304) & 255;
    return w < 128 ? 2304 + 128 * t + w : 3072 + 128 * t + (w - 128);
}
constexpr int NCHUNK = 43008, CH_P2 = 0, CH_P3 = 24576, CH_P0 = 40960, P1_CHUNKS = 8192;
#define CPY_LOAD(V, OKM, CH, in0, in1, in2) { const int c_ = (CH); const int g_ = c_ < 2048 ? 0 : (c_ < 10240 ? 1 : 2); const int n_ = 128 << (2 * g_); \
    const size_t li_ = (size_t)c_ * 512 - (g_ == 0 ? (size_t)0 : (g_ == 1 ? (size_t)1048576 : (size_t)5242880)); \
    const f32x4* s4_ = (const f32x4*)(g_ == 0 ? (in0) : (g_ == 1 ? (in1) : (in2))) + li_ + 64 + lane; OKM = 0u; \
    _Pragma("unroll") for (int u = 0; u < 8; ++u) { const unsigned row_ = (unsigned)((li_ >> 6) + u) & (unsigned)(n_ - 1); \
        if (row_ < (unsigned)(n_ - 1)) { V[u] = __builtin_nontemporal_load(s4_ + u * 64); OKM |= 1u << u; } } }
#define CPY_STORE(V, OKM, CH, outp) { f32x4* d4_ = (f32x4*)((outp) + O_KS0) + (size_t)(CH) * 512 + lane; \
    _Pragma("unroll") for (int u = 0; u < 8; ++u) if ((OKM >> u) & 1u) __builtin_nontemporal_store(V[u], d4_ + u * 64); }

template <class Epi>
__device__ __forceinline__ void small_gemm(LAS unsigned char* lds, const bf16* A, const bf16* Bt, int N, int K, int first_blk, int n_blk, const Epi& E) {
    int tid_ = threadIdx.x; asm volatile("" : "+v"(tid_));
    const int tid = tid_, lane = tid & 63, wid = __builtin_amdgcn_readfirstlane(tid >> 6);
    int bidx = (int)blockIdx.x; asm volatile("" : "+s"(bidx));
    LAS f32x4* red = (LAS f32x4*)lds;
    const int kw = K >> 3;
    if (bidx < first_blk || bidx >= first_blk + n_blk) return;
    for (int unit = bidx - first_blk; unit < (N >> 4); unit += n_blk) {
        const int n0 = unit * 16;
        f32x4 acc0 = {0.f, 0.f, 0.f, 0.f}, acc1 = acc0;
        const bf16* ap = A + (size_t)(lane & 15) * K + wid * kw + 8 * (lane >> 4);
        const bf16* bp = Bt + (size_t)(n0 + (lane & 15)) * K + wid * kw + 8 * (lane >> 4);
        for (int k = 0; k < kw; k += 256) {
            bf16x8 a0[8], a1[8], b[8];
            const bool two = k + 128 < kw;
#pragma unroll
            for (int j = 0; j < 4; ++j) { a0[j] = *(const bf16x8*)(ap + k + 32 * j); a1[j] = *(const bf16x8*)(ap + (size_t)16 * K + k + 32 * j); b[j] = *(const bf16x8*)(bp + k + 32 * j); }
            if (two) {
#pragma unroll
                for (int j = 4; j < 8; ++j) { a0[j] = *(const bf16x8*)(ap + k + 32 * j); a1[j] = *(const bf16x8*)(ap + (size_t)16 * K + k + 32 * j); b[j] = *(const bf16x8*)(bp + k + 32 * j); }
            }
#pragma unroll
            for (int j = 0; j < 4; ++j) { acc0 = __builtin_amdgcn_mfma_f32_16x16x32_bf16(a0[j], b[j], acc0, 0, 0, 0); acc1 = __builtin_amdgcn_mfma_f32_16x16x32_bf16(a1[j], b[j], acc1, 0, 0, 0); }
            if (two) {
#pragma unroll
                for (int j = 4; j < 8; ++j) { acc0 = __builtin_amdgcn_mfma_f32_16x16x32_bf16(a0[j], b[j], acc0, 0, 0, 0); acc1 = __builtin_amdgcn_mfma_f32_16x16x32_bf16(a1[j], b[j], acc1, 0, 0, 0); }
            }
        }
        red[(wid * 2 + 0) * 64 + lane] = acc0; red[(wid * 2 + 1) * 64 + lane] = acc1;
        __syncthreads();
        const int row = tid >> 4, col = tid & 15, t = row >> 4, rr = row & 15, sl = (rr >> 2) * 16 + col, rg = rr & 3;
        float v = 0.f;
#pragma unroll
        for (int w = 0; w < 8; ++w) v += ((LAS float*)(red + (w * 2 + t) * 64 + sl))[rg];
        E(row, col, unit, v);
        __syncthreads();
    }
}
__device__ __forceinline__ float sum16(float v) { v += __shfl_xor(v, 1); v += __shfl_xor(v, 2); v += __shfl_xor(v, 4); v += __shfl_xor(v, 8); return v; }
__device__ __forceinline__ float srow_rs(const float* ssqs, int row, int col) {
    const f32x4 p = *(const f32x4*)(ssqs + row * 64 + col * 4);
    return rsqrtf(sum16((p[0] + p[1]) + (p[2] + p[3])) * (1.f / 1024.f) + 1e-6f);
}
struct SEpiIn { const float* ssqs; float* zs;
    __device__ __forceinline__ void operator()(int row, int col, int unit, float v) const { const float rs = srow_rs(ssqs, row, col); zs[row * DIN + unit * 16 + col] = v * rs; } };
struct SEpiRes { float* xs; bf16* xsb; float* ssqs;
    __device__ __forceinline__ void operator()(int row, int col, int unit, float v) const {
        const int c = unit * 16 + col; const float h = xs[row * 1024 + c] + v; xs[row * 1024 + c] = h;
        const unsigned hb = pk2(h, 0.f); xsb[row * 1024 + c] = (bf16)(hb & 0xffffu);
        const float q = sum16(h * h); if (col == 0) ssqs[row * 64 + unit] = q; } };
struct SEpiUp { const float* ssqs; bf16* fs;
    __device__ __forceinline__ void operator()(int row, int col, int unit, float v) const { const float rs = srow_rs(ssqs, row, col); const float a = fmaxf(v * rs, 0.f);
        const unsigned hb = pk2(a * a, 0.f); fs[row * DFF + unit * 16 + col] = (bf16)(hb & 0xffffu); } };

__device__ __forceinline__ int crow(int r, int hi) { return (r & 3) + 8 * (r >> 2) + 4 * hi; }
__device__ __forceinline__ s16x4 vtr(const LAS unsigned char* p) { typedef short v4i16_t __attribute__((ext_vector_type(4))); return __builtin_bit_cast(s16x4, __builtin_amdgcn_ds_read_tr16_b64_v4i16((LAS v4i16_t*)p)); }
constexpr int VSTR = 192;
constexpr int AK_PITCH = 144, AV_PITCH = 192, AK_BYTES = 384 * AK_PITCH, AV_BYTES = 384 * AV_PITCH;
static_assert(AK_BYTES + AV_BYTES <= LDS_BYTES - 64, "attention LDS map");
struct AttRound { int b, gh, dil, r, c0; };
__device__ __forceinline__ AttRound att_round(int R) {
    AttRound a; const int it = R * 8, cidx = it & 255, bg = it >> 8; a.b = bg / 12; a.gh = bg - a.b * 12; const int g = a.gh >> 2; a.dil = 1 << (2 * g); const int per = 256 >> (2 * g);
    a.r = cidx / per; a.c0 = cidx % per; return a;
}
#define ATT_STAGE_LOAD(PC, QN, A) { const int kb0_ = 32 * (A).c0 - 128; const size_t rs_ = (size_t)(A).dil * 768; \
        const size_t e0_ = ((size_t)(A).b * SEQ + (A).r) * 768 + (A).gh * 64 + (tid & 7) * 8; \
        _Pragma("unroll") for (int j = 0; j < 12; ++j) { const int slot = (tid >> 3) + 64 * (j % 6); PC[j] = (u32x4){0u, 0u, 0u, 0u}; \
            if (kb0_ + slot >= 0) PC[j] = *(const u32x4*)((j < 6 ? Kb : Vb) + e0_ + (size_t)(kb0_ + slot) * rs_); } \
        const bf16* qp_ = Qb + ((size_t)(A).b * SEQ + (size_t)(32 * ((A).c0 + wid) + r32) * (A).dil + (A).r) * 768 + (A).gh * 64 + hi * 8; \
        _Pragma("unroll") for (int d0 = 0; d0 < 4; ++d0) QN[d0] = *(const bf16x8*)(qp_ + d0 * 16); }
#define ATT_STAGE_STORE(PC) { _Pragma("unroll") for (int j = 0; j < 12; ++j) { const int slot = (tid >> 3) + 64 * (j % 6); \
        *(LAS u32x4*)(lds + (j < 6 ? slot * AK_PITCH : AK_BYTES + slot * AV_PITCH) + (tid & 7) * 16) = PC[j]; } }
__device__ __forceinline__ void attn_compute(const LAS unsigned char* lds, const bf16x8 (&qr)[4], bf16* OG, float* LSE, const AttRound& A, int wid, int lane) {
    const int r32 = lane & 31, hi = lane >> 5, i0 = 32 * (A.c0 + wid);
    const size_t rowq = (size_t)A.b * SEQ + (size_t)(i0 + r32) * A.dil + A.r;
    const float NEG = -1e30f;
    float mx = NEG, l = 0.f;
    f32x16 o[2];
#pragma unroll
    for (int g = 0; g < 16; ++g) { o[0][g] = 0.f; o[1][g] = 0.f; }
    const LAS unsigned char* kfb = lds + (32 * wid + r32) * AK_PITCH + hi * 16;
    const LAS unsigned char* trb = lds + AK_BYTES + (32 * wid + 4 * hi + ((lane & 15) >> 2)) * AV_PITCH + ((lane >> 4) & 1) * 32 + (lane & 3) * 8;
#pragma unroll 1
    for (int t = (i0 >= 128 ? 0 : 4 - (i0 >> 5)); t < 5; ++t) {
        f32x16 s = {0.f, 0.f, 0.f, 0.f, 0.f, 0.f, 0.f, 0.f, 0.f, 0.f, 0.f, 0.f, 0.f, 0.f, 0.f, 0.f};
#pragma unroll
        for (int d0 = 0; d0 < 4; ++d0) { const bf16x8 kf = *(const LAS bf16x8*)(kfb + (32 * t) * AK_PITCH + d0 * 32); s = __builtin_amdgcn_mfma_f32_32x32x16_bf16(kf, qr[d0], s, 0, 0, 0); }
        if (t == 0) {
#pragma unroll
            for (int g = 0; g < 16; ++g) if (crow(g, hi) < r32) s[g] = NEG;
        }
        if (t == 4) {
#pragma unroll
            for (int g = 0; g < 16; ++g) if (crow(g, hi) > r32) s[g] = NEG;
        }
        float tm = s[0];
#pragma unroll
        for (int g = 1; g < 16; ++g) tm = fmaxf(tm, s[g]);
        { const auto rr = __builtin_amdgcn_permlane32_swap(__float_as_uint(tm), __float_as_uint(tm), false, false); tm = fmaxf(__uint_as_float(rr[0]), __uint_as_float(rr[1])); }
        const float mn = fmaxf(mx, tm), alpha = __builtin_amdgcn_exp2f(mx - mn);
        mx = mn;
        float ps = 0.f;
#pragma unroll
        for (int g = 0; g < 16; ++g) { const float p = __builtin_amdgcn_exp2f(s[g] - mn); s[g] = p; ps += p; }
        l = l * alpha + ps;
#pragma unroll
        for (int g = 0; g < 16; ++g) { o[0][g] *= alpha; o[1][g] *= alpha; }
        const LAS unsigned char* vt = trb + (32 * t) * AV_PITCH;
#pragma unroll
        for (int sx = 0; sx < 2; ++sx) {
            u32x4 pw; pw.x = pk2(s[8 * sx + 0], s[8 * sx + 1]); pw.y = pk2(s[8 * sx + 2], s[8 * sx + 3]); pw.z = pk2(s[8 * sx + 4], s[8 * sx + 5]); pw.w = pk2(s[8 * sx + 6], s[8 * sx + 7]);
            const bf16x8 pf = __builtin_bit_cast(bf16x8, pw);
#pragma unroll
            for (int d0 = 0; d0 < 2; ++d0) {
                const s16x4 lo = vtr(vt + (16 * sx) * AV_PITCH + d0 * 64), hh = vtr(vt + (16 * sx + 8) * AV_PITCH + d0 * 64);
                const bf16x8 vf = {lo[0], lo[1], lo[2], lo[3], hh[0], hh[1], hh[2], hh[3]};
                o[d0] = __builtin_amdgcn_mfma_f32_32x32x16_bf16(vf, pf, o[d0], 0, 0, 0);
            }
        }
    }
    { const auto rr = __builtin_amdgcn_permlane32_swap(__float_as_uint(l), __float_as_uint(l), false, false); l = __uint_as_float(rr[0]) + __uint_as_float(rr[1]); }
    const float rl = 1.f / l;
    bf16* op = OG + rowq * 768 + A.gh * 64;
#pragma unroll
    for (int d0 = 0; d0 < 2; ++d0)
#pragma unroll
        for (int a = 0; a < 4; ++a) {
            const f32x4 v = {o[d0][4 * a] * rl, o[d0][4 * a + 1] * rl, o[d0][4 * a + 2] * rl, o[d0][4 * a + 3] * rl};
            st4bf(op + 32 * d0 + 8 * a + 4 * hi, v);
        }
    if (hi == 0) LSE[rowq * 12 + A.gh] = mx + __builtin_amdgcn_logf(l);
}
__device__ __forceinline__ void sattn_block(LAS unsigned char* lds, const float* zs, const float* cs, const float* cache, float* outkv, float* ogs, float* lses, int layer, int b, int h, int g, int lane, int wid) {
    const int n = 128 << (2 * g), dil = 1 << (2 * g);
    LAS float* sh = (LAS float*)lds;
    LAS float* qs = sh + 1024 + wid * 128;
    const float* zr = zs + b * DIN + g * 256 + h * 64 + lane;
    float q = zr[0], k = zr[768], v = zr[1536];
    { const float qo = __shfl_xor(q, 8), ko = __shfl_xor(k, 8);
      if (lane < 16) { const float c = cs[8192 * 16 + (lane & 7)], s = cs[8192 * 16 + 8 + (lane & 7)], sg = lane < 8 ? -1.f : 1.f; q = q * c + sg * qo * s; k = k * c + sg * ko * s; } }
    const size_t cb = ((size_t)(layer * SB + b) * 2) * n * 256;
    const float* kc = cache + cb + h * 64; const float* vc = kc + (size_t)n * 256;
    if (wid == 0) { float* ok = outkv + cb + h * 64; float* ov = ok + (size_t)n * 256; ok[(size_t)(n - 1) * 256 + lane] = k; ov[(size_t)(n - 1) * 256 + lane] = v; }
    q *= C2;
    qs[lane] = q; qs[64 + lane] = v;
    const int kk = lane >> 2, qd = lane & 3, jg = lane >> 4, d4 = lane & 15;
    f32x4 kv4[4], vv4[4];
    { const float* kr = kc + (size_t)(n - dil * (1 + 16 * wid + kk)) * 256 + 16 * qd;
#pragma unroll
      for (int i = 0; i < 4; ++i) kv4[i] = *(const f32x4*)(kr + 4 * i);
#pragma unroll
      for (int i = 0; i < 4; ++i) vv4[i] = *(const f32x4*)(vc + (size_t)(n - dil * (1 + 16 * wid + 4 * jg + i)) * 256 + 4 * d4); }
    asm volatile("s_waitcnt lgkmcnt(0)" ::: "memory");
    float a = 0.f;
#pragma unroll
    for (int i = 0; i < 4; ++i) { const f32x4 qv = *(const LAS f32x4*)(qs + 16 * qd + 4 * i); a += (kv4[i][0] * qv[0] + kv4[i][1] * qv[1]) + (kv4[i][2] * qv[2] + kv4[i][3] * qv[3]); }
    a += __shfl_xor(a, 1); a += __shfl_xor(a, 2);
    float m = wave_max(a), snew = 0.f;
    if (wid == 0) { snew = wave_sum(q * k); m = fmaxf(m, snew); }
    const float p = __builtin_amdgcn_exp2f(a - m);
    float lsum = wave_sum(p) * 0.25f, pn = 0.f;
    if (wid == 0) { pn = __builtin_amdgcn_exp2f(snew - m); lsum += pn; }
    f32x4 oacc = {0.f, 0.f, 0.f, 0.f};
#pragma unroll
    for (int i = 0; i < 4; ++i) { const float pp = __shfl(p, (4 * jg + i) * 4); oacc += vv4[i] * pp; }
#pragma unroll
    for (int i = 0; i < 4; ++i) { oacc[i] += __shfl_xor(oacc[i], 16); oacc[i] += __shfl_xor(oacc[i], 32); }
    if (jg == 0) { const f32x4 vn = *(const LAS f32x4*)(qs + 64 + 4 * d4); *(LAS f32x4*)(sh + wid * 72 + 4 * d4) = oacc + vn * pn; }
    if (lane == 0) { sh[wid * 72 + 64] = m; sh[wid * 72 + 65] = lsum; }
    __syncthreads();
    if (wid == 0) {
        float M = sh[64];
#pragma unroll
        for (int w = 1; w < 8; ++w) M = fmaxf(M, sh[w * 72 + 64]);
        float L = 0.f, o = 0.f;
#pragma unroll
        for (int w = 0; w < 8; ++w) { const float f = __builtin_amdgcn_exp2f(sh[w * 72 + 64] - M); L += sh[w * 72 + 65] * f; o += sh[w * 72 + lane] * f; }
        ogs[b * 768 + g * 256 + h * 64 + lane] = o / L;
        if (lane == 0) lses[b * 12 + g * 4 + h] = M + __builtin_amdgcn_logf(L);
    }
    __syncthreads();
}

constexpr int P3_UROWS = 32 + CW - 1, P3_TAPS = 36  , P3_OFF_W = 64 * CONV * 2  , P3_OFF_C = P3_OFF_W + P3_TAPS * CONV * 2, P3_OFF_RED = P3_OFF_C + 3 * CONV * 4;
static_assert(P3_OFF_RED + 64 <= LDS_BYTES, "phase 3 LDS map");
__device__ __forceinline__ void p3_stage_weights(LAS unsigned char* lds, int layer, const float* conv_w, const float* conv_b, const float* ln_g, const float* ln_b, int tid) {
    const f32x4* cw4 = (const f32x4*)(conv_w + (size_t)layer * CW * CONV);
    f32x4 wv[12];
#pragma unroll
    for (int j = 0; j < 12; ++j) { const int i = tid + 512 * j; if (i < CW * 192) wv[j] = cw4[i]; }
#pragma unroll
    for (int j = 0; j < 12; ++j) { const int i = tid + 512 * j; if (i < CW * 192) { u32x2 p; p.x = pk2(wv[j][0], wv[j][1]); p.y = pk2(wv[j][2], wv[j][3]); ((LAS u32x2*)(lds + P3_OFF_W))[i] = p; } }
    unsigned zz = 0u; asm volatile("" : "+v"(zz));
    for (int i = tid; i < (P3_TAPS - CW) * 192; i += 512) ((LAS u32x2*)(lds + P3_OFF_W))[CW * 192 + i] = (u32x2){zz, zz};
    if (tid < 192) { ((LAS u32x4*)(lds + P3_UROWS * CONV * 2))[tid] = (u32x4){zz, zz, zz, zz};
        LAS f32x4* c4 = (LAS f32x4*)(lds + P3_OFF_C); c4[tid] = ((const f32x4*)(conv_b + layer * CONV))[tid]; c4[192 + tid] = ((const f32x4*)(ln_g + layer * CONV))[tid]; c4[384 + tid] = ((const f32x4*)(ln_b + layer * CONV))[tid]; }
}
#define P3_LOAD(V, TILE) { const size_t row0_ = (size_t)(TILE) * 32; const int b_ = (int)(row0_ >> 13), s0_ = (int)(row0_ & 8191); \
        _Pragma("unroll") for (int i = 0; i < 12; ++i) { const int idx = tid + 512 * i, ri = idx / 96, c16 = idx - ri * 96, sp = s0_ - (CW - 1) + ri; V[i] = (u32x4){0u, 0u, 0u, 0u}; \
            if (idx < P3_UROWS * 96 && sp >= 0) V[i] = *(const u32x4*)(Ub + ((size_t)(b_ << 13) + sp) * 768 + c16 * 8); } }
#define P3_TO_LDS(V) { _Pragma("unroll") for (int i = 0; i < 12; ++i) { const int idx = tid + 512 * i; if (idx < P3_UROWS * 96) *(LAS u32x4*)(lds + idx * 16) = V[i]; } }
template <int NT>
__device__ __forceinline__ void p3_merge(size_t rw, const bf16* OG, const float* LSE, bf16* CAT, int lane) {
    const int h = lane >> 4, d4 = (lane & 15) * 4;
    float l0[NT], l1[NT], l2[NT]; u32x2 a0[NT], a1[NT], a2[NT];
#pragma unroll
    for (int tk = 0; tk < NT; ++tk) { const size_t row = rw + tk; l0[tk] = LSE[row * 12 + h]; l1[tk] = LSE[row * 12 + 4 + h]; l2[tk] = LSE[row * 12 + 8 + h];
        a0[tk] = *(const u32x2*)(OG + row * 768 + h * 64 + d4); a1[tk] = *(const u32x2*)(OG + row * 768 + 256 + h * 64 + d4); a2[tk] = *(const u32x2*)(OG + row * 768 + 512 + h * 64 + d4); }
#pragma unroll
    for (int tk = 0; tk < NT; ++tk) {
        const float lm = fmaxf(l0[tk], fmaxf(l1[tk], l2[tk])); const float w0 = __builtin_amdgcn_exp2f(l0[tk] - lm), w1 = __builtin_amdgcn_exp2f(l1[tk] - lm), w2 = __builtin_amdgcn_exp2f(l2[tk] - lm); const float wi = 1.f / (w0 + w1 + w2);
        const f32x4 f0 = {bflo(a0[tk].x), bfhi(a0[tk].x), bflo(a0[tk].y), bfhi(a0[tk].y)}, f1 = {bflo(a1[tk].x), bfhi(a1[tk].x), bflo(a1[tk].y), bfhi(a1[tk].y)}, f2 = {bflo(a2[tk].x), bfhi(a2[tk].x), bflo(a2[tk].y), bfhi(a2[tk].y)};
        st4bf(CAT + (rw + tk) * 1024 + h * 64 + d4, (f0 * w0 + f1 * w1 + f2 * w2) * wi);
    }
}
__device__ __forceinline__ void p3_conv(LAS unsigned char* lds, int tile, bf16* CAT, int lane, int wid) {
    const size_t rw = (size_t)tile * 32 + 4 * wid;
    const f32x4 zero4 = {0.f, 0.f, 0.f, 0.f};
    const LAS f32x4* c4 = (const LAS f32x4*)(lds + P3_OFF_C);
    f32x4 acc[3][4];
#pragma unroll
    for (int k = 0; k < 3; ++k) {
        const int cq = lane + 64 * k;
        const LAS unsigned char* up = lds + (4 * wid) * (CONV * 2) + cq * 8;
        const LAS unsigned char* wp = lds + P3_OFF_W + cq * 8;
        const f32x4 bias = c4[cq];
        acc[k][0] = bias; acc[k][1] = bias; acc[k][2] = bias; acc[k][3] = bias;
        f32x4 wa = zero4, wb = zero4, wc = zero4, wd = zero4;
#define CONV_STEP(I, WNEW, W1, W2, W3) { const u32x2 wr_ = *(const LAS u32x2*)(wq + (I) * (CONV * 2)); WNEW = (f32x4){bflo(wr_.x), bfhi(wr_.x), bflo(wr_.y), bfhi(wr_.y)}; \
            const u32x2 ux_ = *(const LAS u32x2*)(uq + (I) * (CONV * 2)); const f32x4 uv_ = {bflo(ux_.x), bfhi(ux_.x), bflo(ux_.y), bfhi(ux_.y)}; \
            acc[k][0] += uv_ * WNEW; acc[k][1] += uv_ * W1; acc[k][2] += uv_ * W2; acc[k][3] += uv_ * W3; }
        const LAS unsigned char* uq = up; const LAS unsigned char* wq = wp;
#pragma unroll 3
        for (int w = 0; w < P3_TAPS; w += 4) {
            CONV_STEP(0, wa, wd, wc, wb) CONV_STEP(1, wb, wa, wd, wc) CONV_STEP(2, wc, wb, wa, wd) CONV_STEP(3, wd, wc, wb, wa)
            uq += 4 * CONV * 2; wq += 4 * CONV * 2;
        }
#undef CONV_STEP
    }
#pragma unroll
    for (int o = 0; o < 4; ++o) {
        float sm = 0.f;
#pragma unroll
        for (int k = 0; k < 3; ++k) sm += (acc[k][o][0] + acc[k][o][1]) + (acc[k][o][2] + acc[k][o][3]);
        const float mu = wave_sum(sm) * (1.f / CONV); float sq = 0.f;
#pragma unroll
        for (int k = 0; k < 3; ++k) { const f32x4 d = acc[k][o] - mu; acc[k][o] = d; sq += (d[0] * d[0] + d[1] * d[1]) + (d[2] * d[2] + d[3] * d[3]); }
        const float rstd = rsqrtf(wave_sum(sq) * (1.f / CONV) + 1e-5f);
#pragma unroll
        for (int k = 0; k < 3; ++k) { const int cq = lane + 64 * k; f32x4 y = acc[k][o] * rstd * c4[192 + cq] + c4[384 + cq];
#pragma unroll
            for (int i = 0; i < 4; ++i) y[i] = y[i] * __builtin_amdgcn_rcpf(1.f + __expf(-y[i]));
            st4bf(CAT + (rw + o) * 1024 + 256 + 4 * cq, y); }
    }
}
__device__ __forceinline__ void sconv_item(int layer, int b, int k, const float* zs, const float* state, float* outconv, const float* conv_w, const float* conv_b, float* cvs, int lane) {
    const int c = 64 * k + lane, zc = 2304 + 256 * (c >> 7) + (c & 127);
    const float* st = state + (size_t)(layer * SB + b) * 30 * CONV + c; const float* cwp = conv_w + (size_t)layer * CW * CONV + c;
    float sv[30], wv[31];
#pragma unroll
    for (int w = 0; w < 30; ++w) { sv[w] = st[w * CONV]; wv[w] = cwp[w * CONV]; }
    wv[30] = cwp[30 * CONV];
    const float a = zs[b * DIN + zc], gt = zs[b * DIN + zc + 128]; const float u = a * __builtin_amdgcn_rcpf(1.f + __expf(-gt));
    outconv[((size_t)(layer * SB + b) * 30 + 29) * CONV + c] = u;
    float acc = conv_b[layer * CONV + c] + u * wv[30];
#pragma unroll
    for (int w = 0; w < 30; ++w) acc += sv[w] * wv[w];
    cvs[b * CONV + c] = acc;
}
__device__ __forceinline__ void p3_sample(LAS unsigned char* lds, int layer, int b, const float* ogs, const float* lses, bf16* cats, const float* cvs, const float* ln_g, const float* ln_b, int tid, int lane, int wid) {
    LAS float* red = (LAS float*)(lds + P3_OFF_RED);
    if (tid < 256) {
        const int h = tid >> 6, d = tid & 63;
        const float l0 = lses[b * 12 + h], l1 = lses[b * 12 + 4 + h], l2 = lses[b * 12 + 8 + h];
        const float lm = fmaxf(l0, fmaxf(l1, l2)); const float w0 = __builtin_amdgcn_exp2f(l0 - lm), w1 = __builtin_amdgcn_exp2f(l1 - lm), w2 = __builtin_amdgcn_exp2f(l2 - lm);
        const float att = (ogs[b * 768 + tid] * w0 + ogs[b * 768 + 256 + tid] * w1 + ogs[b * 768 + 512 + tid] * w2) / (w0 + w1 + w2);
        cats[b * 1024 + h * 64 + d] = (bf16)(pk2(att, 0.f) & 0xffffu);
    }
    float cv[2]; float sm = 0.f;
#pragma unroll
    for (int e = 0; e < 2; ++e) { const int c = tid + 512 * e; cv[e] = 0.f; if (c < CONV) { cv[e] = cvs[b * CONV + c]; sm += cv[e]; } }
    sm = wave_sum(sm); if (lane == 0) red[wid] = sm;
    __syncthreads();
    float mu = 0.f;
#pragma unroll
    for (int w = 0; w < 8; ++w) mu += red[w];
    mu *= (1.f / CONV);
    float sq = 0.f;
#pragma unroll
    for (int e = 0; e < 2; ++e) { const int c = tid + 512 * e; if (c < CONV) { const float d = cv[e] - mu; sq += d * d; } }
    sq = wave_sum(sq); if (lane == 0) red[8 + wid] = sq;
    __syncthreads();
    float var = 0.f;
#pragma unroll
    for (int w = 0; w < 8; ++w) var += red[8 + w];
    const float rstd = rsqrtf(var * (1.f / CONV) + 1e-5f);
#pragma unroll
    for (int e = 0; e < 2; ++e) { const int c = tid + 512 * e; if (c < CONV) { float y = (cv[e] - mu) * rstd * ln_g[layer * CONV + c] + ln_b[layer * CONV + c]; y = y * __builtin_amdgcn_rcpf(1.f + __expf(-y)); cats[b * 1024 + 256 + c] = (bf16)(pk2(y, 0.f) & 0xffffu); } }
    __syncthreads();
}
#define XB_TMO      128
#define XB_XCNT(j)  (256  + 64 * (j))
#define XB_XSUB(j)  (1280 + 64 * (j))
#define XB_XGEN(j)  (2304 + 64 * (j))
#define XB_TOP      3328
#define XB_TOPGEN   3392
#define XCD_BAR_WORDS 3456
#define XB_SPIN_CAP (1u << 18)

__device__ __forceinline__ unsigned xb_ld(unsigned* p)              { return __hip_atomic_load(p, __ATOMIC_RELAXED, __HIP_MEMORY_SCOPE_AGENT); }
__device__ __forceinline__ unsigned xb_add(unsigned* p, unsigned v) { return __hip_atomic_fetch_add(p, v, __ATOMIC_RELAXED, __HIP_MEMORY_SCOPE_AGENT); }
__device__ __forceinline__ unsigned xb_xcc_id() { return (unsigned)__builtin_amdgcn_s_getreg((3 << 11) | 20) & 0xFu; }
#define XB_SPIN(cond, bar) do { unsigned _sp = 0; while (cond) { __builtin_amdgcn_s_sleep(1); \
    if ((++_sp & 255u) == 0u) { if (xb_ld(&(bar)[XB_TMO])) break; if (_sp > XB_SPIN_CAP) { atomicAdd(&(bar)[XB_TMO], 1u); break; } } } } while (0)

struct XcdBarrier {
    unsigned* bar; unsigned x;
    volatile LAS unsigned* st;
};

__device__ __forceinline__ XcdBarrier xcd_barrier_post(unsigned* bar, volatile LAS unsigned* st) {
    XcdBarrier b; b.bar = bar; b.x = xb_xcc_id(); b.st = st;
    if (threadIdx.x == 0) (void)xb_add(&bar[XB_XCNT(b.x)], 1u);
    return b;
}
__device__ __forceinline__ void xcd_barrier_complete(unsigned* bar, unsigned x, unsigned& nloc, unsigned& nx) {
    const unsigned G = gridDim.x * gridDim.y * gridDim.z;
    unsigned sum, cnt, mine, sp = 0u;
    for (;;) {
        sum = 0u; cnt = 0u; mine = 0u;
#pragma unroll
        for (unsigned j = 0; j < 16; ++j) { const unsigned c = xb_ld(&bar[XB_XCNT(j)]); sum += c; cnt += (c > 0u) ? 1u : 0u; mine = (j == x) ? c : mine; }
        if (sum == G) break;
        __builtin_amdgcn_s_sleep(1);
        if ((++sp & 255u) == 0u) { if (xb_ld(&bar[XB_TMO])) break; if (sp > XB_SPIN_CAP) { atomicAdd(&bar[XB_TMO], 1u); break; } }
    }
    nloc = mine > 0u ? mine : 1u; nx = cnt > 0u ? cnt : 1u;
}

__device__ __forceinline__ void xcd_barrier(const XcdBarrier& b) {
    asm volatile("s_waitcnt vmcnt(0)" ::: "memory");
    __syncthreads();
    if (threadIdx.x == 0) {
        unsigned* bar = b.bar;
        __builtin_amdgcn_s_waitcnt(0);
        unsigned nloc = b.st[0], nx = b.st[1];
        if (nloc == 0u) { xcd_barrier_complete(bar, b.x, nloc, nx); b.st[0] = nloc; b.st[1] = nx; }
        const unsigned old = xb_add(&bar[XB_XSUB(b.x)], 1u);
        const unsigned gen = old / nloc;
        if (old + 1u == (gen + 1u) * nloc) {
            __builtin_amdgcn_fence(__ATOMIC_RELEASE, "agent");
            asm volatile("s_waitcnt vmcnt(0)" ::: "memory");
            const unsigned og = xb_add(&bar[XB_TOP], 1u);
            const unsigned tg = og / nx;
            if (og + 1u == (tg + 1u) * nx) xb_add(&bar[XB_TOPGEN], 1u);
            else XB_SPIN(xb_ld(&bar[XB_TOPGEN]) == tg, bar);
            __builtin_amdgcn_fence(__ATOMIC_ACQUIRE, "agent");
            xb_add(&bar[XB_XGEN(b.x)], 1u);
            asm volatile("s_waitcnt vmcnt(0)" ::: "memory");
        } else {
            XB_SPIN(xb_ld(&bar[XB_XGEN(b.x)]) == gen, bar);
            __builtin_amdgcn_fence(__ATOMIC_ACQUIRE, "agent");
            asm volatile("s_waitcnt vmcnt(0)" ::: "memory");
        }
    }
    __syncthreads();
}
struct Args { const float* in[17]; float* out; unsigned char* ws; double inv[8]; };
typedef const __attribute__((address_space(4))) Args* KArgs;
#define KARGS(kp) KArgs kp = (KArgs)__builtin_amdgcn_kernarg_segment_ptr(); asm volatile("" : "+s"(kp))
#define IDS() int tid_ = threadIdx.x, G_ = (int)gridDim.x, bx_ = (int)blockIdx.x; asm volatile("" : "+v"(tid_), "+s"(G_), "+s"(bx_)); \
    const int tid = tid_, lane = tid & 63, wid = __builtin_amdgcn_readfirstlane(tid >> 6), G = G_, bx = bx_; (void)lane; (void)wid; (void)G; (void)bx
struct LayerW { const bf16 *in, *o, *up, *dn; };
__device__ __forceinline__ unsigned char* wl_of(unsigned char* ws, int layer) { return ws + WS_W + (size_t)layer * W_LSTRIDE; }

__device__ __forceinline__ void phase0(LAS unsigned char* lds) {
    KARGS(kp); IDS();
    const int gw = bx * 8 + wid, NGW = G * 8; const size_t gtid = (size_t)bx * 512 + tid, nthr = (size_t)G * 512;
    unsigned char* ws = kp->ws; float* out = kp->out;
    LAS float* scr = (LAS float*)(lds + wid * 16384);
    constexpr int I_IN = 16 * 120, I_O = 16 * 32, I_UP = 16 * 128, I_DN = 64 * 32, I_L = I_IN + I_O + I_UP + I_DN;
    for (int it = gw; it < DEPTH * I_L; it += NGW) {
        const int l = it / I_L; int r = it - l * I_L;
        unsigned char* wl = wl_of(ws, l);
        if (r < I_IN) { const int kb = r / 120, nb = r % 120; p0_transpose_item(kp->in[6] + (size_t)l * D * DIN, D, DIN, win_srccol(32 * nb), kp->in[12] + l * D, (bf16*)(wl + W_IN), 32 * nb, scr, 64 * kb, lane); continue; } r -= I_IN;
        if (r < I_O) { const int kb = r / 32, nb = r % 32; p0_transpose_item(kp->in[7] + (size_t)l * D * D, D, D, 32 * nb, nullptr, (bf16*)(wl + W_O), 32 * nb, scr, 64 * kb, lane); continue; } r -= I_O;
        if (r < I_UP) { const int kb = r / 128, nb = r % 128; p0_transpose_item(kp->in[14] + (size_t)l * D * DFF, D, DFF, 32 * nb, kp->in[13] + l * D, (bf16*)(wl + W_UP), 32 * nb, scr, 64 * kb, lane); continue; } r -= I_UP;
        { const int kb = r / 32, nb = r % 32; p0_transpose_item(kp->in[15] + (size_t)l * DFF * D, DFF, D, 32 * nb, nullptr, (bf16*)(wl + W_DN), 32 * nb, scr, 64 * kb, lane); }
    }
    {
        const float* x_prompt = kp->in[0]; const float* x_sample = kp->in[1];
        bf16* XB = (bf16*)(ws + WS_XB); float* SSQ = (float*)(ws + WS_SSQ); unsigned char* sm = ws + WS_SMALL;
        float* XS = (float*)(sm + SM_XS); bf16* XSB = (bf16*)(sm + SM_XSB); float* SSQS = (float*)(sm + SM_SSQS);
        for (int m0 = gw; m0 < MP + SB; m0 += 4 * NGW) {
            f32x4 v[4][4];
#pragma unroll
            for (int u = 0; u < 4; ++u) { const int m = m0 + u * NGW; const bool smp = m >= MP; const int mr = smp ? m - MP : m;
                if (m < MP + SB) { const f32x4* xr = (const f32x4*)((smp ? x_sample : x_prompt) + (size_t)mr * D) + lane;
#pragma unroll
                    for (int j = 0; j < 4; ++j) v[u][j] = __builtin_nontemporal_load(xr + 64 * j); } }
#pragma unroll
            for (int u = 0; u < 4; ++u) { const int m = m0 + u * NGW; const bool smp = m >= MP; const int mr = smp ? m - MP : m;
                if (m < MP + SB) { bf16* orow = (smp ? XSB : XB) + (size_t)mr * D; float q = 0.f;
#pragma unroll
                    for (int j = 0; j < 4; ++j) { const f32x4 x = v[u][j]; q += (x[0] * x[0] + x[1] * x[1]) + (x[2] * x[2] + x[3] * x[3]); st4bf(orow + 4 * lane + 256 * j, x); if (smp) *(f32x4*)(XS + (size_t)mr * D + 4 * lane + 256 * j) = x; }
                    q = wave_sum(q);
                    if (smp) SSQS[mr * 64 + lane] = lane == 0 ? q : 0.f;
                    else if (lane < 16) SSQ[(size_t)mr * 16 + lane] = lane == 0 ? q : 0.f; } }
        }
    }
    {
        float* CS = (float*)(ws + WS_CS);
        for (size_t i = gtid; i < (size_t)8193 * 8; i += nthr) {
            const int p = (int)(i >> 3), f = (int)(i & 7); const double pos = p < 8192 ? (double)p : (double)PAST;
            double rev = pos * kp->inv[f] * 0.15915494309189535; rev -= __builtin_rint(rev);
            const float fr = (float)rev; CS[p * 16 + f] = __builtin_amdgcn_cosf(fr); CS[p * 16 + 8 + f] = __builtin_amdgcn_sinf(fr);
        }
    }
    { const float* in0 = kp->in[2]; const float* in1 = kp->in[3]; const float* in2 = kp->in[4];
#pragma unroll 1
      for (int ch = (G == 256 ? CH_P0 : 0) + gw; ch < NCHUNK; ch += NGW) { f32x4 cv[8]; unsigned okm; CPY_LOAD(cv, okm, ch, in0, in1, in2) CPY_STORE(cv, okm, ch, out) } }
    { const f32x4* st4 = (const f32x4*)kp->in[5]; f32x4* oc4 = (f32x4*)(out + O_CS);
      for (size_t i = gtid; i < (size_t)DEPTH * SB * 30 * (CONV / 4); i += nthr) { const unsigned w = (unsigned)(i % (30 * (CONV / 4))); if (w < 29 * (CONV / 4)) oc4[i] = st4[i + CONV / 4]; } }
}

__device__ __forceinline__ void phase1(LAS unsigned char* lds, int layer) {
    KARGS(kp); IDS();
    unsigned char* ws = kp->ws; unsigned char* sm = ws + WS_SMALL;
    const bf16* Win_t = (const bf16*)(wl_of(ws, layer) + W_IN);
    pg8::Gemm g{(const bf16*)(ws + WS_XB), Win_t, MP, DIN, D}; pg8::StaticOrder S; S.init(MP, DIN, G, bx);
    pg8::EpiIn E{(const float*)(ws + WS_SSQ), (const float*)(ws + WS_CS), (bf16*)(ws + WS_Q), (WS_K - WS_Q) / 2, (bf16*)(ws + WS_U)};
    SEpiIn SE{(const float*)(sm + SM_SSQS), (float*)(sm + SM_ZS)};
    small_gemm(lds, (const bf16*)(sm + SM_XSB), Win_t, DIN, D, G / 2, G - G / 2, SE);
    pg8::gemm_phase<pg8::EpiIn, pg8::StaticOrder, true, true>(lds, g, S, E);
    if (G == 256 && bx >= 128) {
        const float* in0 = kp->in[2]; const float* in1 = kp->in[3]; const float* in2 = kp->in[4]; float* outp = kp->out;
        const int c0 = CH_P2 + layer * (NB * 12 * 256) + ((bx - 128) * 8 + wid) * (P1_CHUNKS / 1024);
#pragma unroll 1
        for (int j = 0; j < P1_CHUNKS / 1024; j += 2) {
            f32x4 ca[8], cb[8]; unsigned ma, mb;
            CPY_LOAD(ca, ma, c0 + j, in0, in1, in2) CPY_LOAD(cb, mb, c0 + j + 1, in0, in1, in2)
            CPY_STORE(ca, ma, c0 + j, outp) CPY_STORE(cb, mb, c0 + j + 1, outp)
        }
    }
}

__device__ __forceinline__ void phase2(LAS unsigned char* lds, int layer) {
    KARGS(kp); IDS();
    unsigned char* ws = kp->ws; unsigned char* sm = ws + WS_SMALL; float* out = kp->out;
    const int gw = bx * 8 + wid, NGW = G * 8;
    LAS unsigned char* vst = lds + wid * 8192;
    const bf16* Qb = (const bf16*)(ws + WS_Q); bf16* OGb = (bf16*)(ws + WS_OG); const bf16* Kb = (const bf16*)(ws + WS_K); const bf16* Vb = (const bf16*)(ws + WS_V); float* LSE = (float*)(ws + WS_LSE);
#ifndef NO_2A
    { const float* in0 = kp->in[2]; const float* in1 = kp->in[3]; const float* in2 = kp->in[4]; const bool ride = G == 256;
      const int r32 = lane & 31, hi = lane >> 5; constexpr int NR = NB * 12 * 256 / 8;
      u32x4 pc[12]; bf16x8 qn[4], qr[4];
      int R = bx;
      if (R < NR) { const AttRound A = att_round(R); ATT_STAGE_LOAD(pc, qn, A) }
#pragma unroll 1
      for (; R < NR; R += G) {
          const AttRound A = att_round(R);
          ATT_STAGE_STORE(pc)
#pragma unroll
          for (int d0 = 0; d0 < 4; ++d0) qr[d0] = qn[d0];
          __syncthreads();
          if (R + G < NR) { const AttRound An = att_round(R + G); ATT_STAGE_LOAD(pc, qn, An) }
          f32x4 cv[8]; unsigned okm = 0u; const int ch = CH_P2 + layer * (NB * 12 * 256) + R * 8 + wid;
          if (ride && R * 8 + wid >= P1_CHUNKS) CPY_LOAD(cv, okm, ch, in0, in1, in2)
          attn_compute(lds, qr, OGb, LSE, A, wid, lane);
          CPY_STORE(cv, okm, ch, out)
          __syncthreads();
      } }
#pragma unroll 1
    for (int si = bx; si < SB * 12; si += G) { const int b = si / 12, hg = si - b * 12, g = hg >> 2, h = hg & 3;
        const float* cache = g == 0 ? kp->in[2] : (g == 1 ? kp->in[3] : kp->in[4]); float* okv = out + (g == 0 ? O_KS0 : (g == 1 ? O_KS1 : O_KS2));
        sattn_block(lds, (const float*)(sm + SM_ZS), (const float*)(ws + WS_CS), cache, okv, (float*)(sm + SM_OGS), (float*)(sm + SM_LSES), layer, b, h, g, lane, wid); }
    if (wid == 2 || wid == 3) { for (int si = (wid - 2) * G + bx; si < SB * 12; si += 2 * G) sconv_item(layer, si / 12, si % 12, (const float*)(sm + SM_ZS), kp->in[5], out + O_CS, kp->in[8], kp->in[9], (float*)(sm + SM_CVS), lane); }
#endif
#ifndef NO_2C
    {
        const size_t gtid = (size_t)bx * 512 + tid, nthr = (size_t)G * 512;
        const bf16* Ub = (const bf16*)(ws + WS_U);
#pragma unroll 1
        for (int g = 0; g < 3; ++g) {
            const int keep = 128 << (2 * g); float* ob = out + (g == 0 ? O_KP0 : (g == 1 ? O_KP1 : O_KP2)) + (size_t)layer * NB * 2 * keep * 256;
            const int total = NB * 2 * keep * 64, lk = 7 + 2 * g;
            for (int i = (int)gtid; i < total; i += (int)nthr) {
                const int c4 = i & 63, rr = i >> 6, j = rr & (keep - 1), bk = rr >> lk, kv = bk & 1, b = bk >> 1;
                const bf16* src = (kv ? Vb : Kb) + ((size_t)b * SEQ + (SEQ - keep) + j) * 768 + g * 256 + c4 * 4;
                *(f32x4*)(ob + (size_t)i * 4) = ld4bf(src);
            }
        }
        float* oc = out + O_CP + (size_t)layer * NB * 30 * CONV;
        for (size_t i = gtid; i < (size_t)NB * 30 * (CONV / 4); i += nthr) {
            const int c4 = (int)(i % (CONV / 4)); const size_t rr = i / (CONV / 4); const int j = (int)(rr % 30), b = (int)(rr / 30);
            *(f32x4*)(oc + i * 4) = ld4bf(Ub + ((size_t)b * SEQ + (SEQ - 30) + j) * 768 + c4 * 4);
        }
    }
#endif
}

__device__ __forceinline__ void phase3(LAS unsigned char* lds, int layer) {
    KARGS(kp); IDS();
    unsigned char* ws = kp->ws; unsigned char* sm = ws + WS_SMALL;
    p3_stage_weights(lds, layer, kp->in[8], kp->in[9], kp->in[10], kp->in[11], tid);
    {
        const bf16* Ub = (const bf16*)(ws + WS_U); const bf16* OGb = (const bf16*)(ws + WS_OG); const float* LSE = (const float*)(ws + WS_LSE); bf16* CAT = (bf16*)(ws + WS_CAT);
        u32x4 v[12];
        int tile = bx;
        const float* in0 = kp->in[2]; const float* in1 = kp->in[3]; const float* in2 = kp->in[4]; float* outp = kp->out;
        if (tile < MP / 32) P3_LOAD(v, tile)
#pragma unroll 1
        for (int t2 = bx; t2 < MP / 32; t2 += 2 * G) {
            p3_merge<4>((size_t)t2 * 32 + 4 * wid, OGb, LSE, CAT, lane);
            if (t2 + G < MP / 32) p3_merge<4>((size_t)(t2 + G) * 32 + 4 * wid, OGb, LSE, CAT, lane);
        }
#pragma unroll 1
        for (; tile < MP / 32; tile += G) {
            P3_TO_LDS(v)
            __syncthreads();
            if (tile + G < MP / 32) P3_LOAD(v, tile + G)
            f32x4 cv[8]; unsigned okm = 0u; const int ch = CH_P3 + ((layer * 4 + (tile - bx) / G) * 256 + bx) * 8 + wid;
            if (G == 256) CPY_LOAD(cv, okm, ch, in0, in1, in2)
            p3_conv(lds, tile, CAT, lane, wid);
            CPY_STORE(cv, okm, ch, outp)
            __syncthreads();
        }
    }
    if (bx < SB) p3_sample(lds, layer, bx, (const float*)(sm + SM_OGS), (const float*)(sm + SM_LSES), (bf16*)(sm + SM_CATS), (const float*)(sm + SM_CVS), kp->in[10], kp->in[11], tid, lane, wid);
}

__device__ __forceinline__ void phase4(LAS unsigned char* lds, int layer, bool do_small = true) {
    KARGS(kp); IDS();
    unsigned char* ws = kp->ws; unsigned char* sm = ws + WS_SMALL;
    const bf16* Wo_t = (const bf16*)(wl_of(ws, layer) + W_O);
    pg8::Gemm g{(const bf16*)(ws + WS_CAT), Wo_t, MP, D, D}; pg8::StaticOrder S; S.init(MP, D, G, bx);
    pg8::EpiRes E{(bf16*)(ws + WS_XB), (float*)(ws + WS_SSQ)};
    SEpiRes SE{(float*)(sm + SM_XS), (bf16*)(sm + SM_XSB), (float*)(sm + SM_SSQS)};
    if (do_small) small_gemm(lds, (const bf16*)(sm + SM_CATS), Wo_t, D, D, 0, G, SE);
    pg8::gemm_phase<pg8::EpiRes, pg8::StaticOrder, true, true>(lds, g, S, E);
}

__device__ __forceinline__ void phase5(LAS unsigned char* lds, int layer) {
    KARGS(kp); IDS();
    unsigned char* ws = kp->ws; unsigned char* sm = ws + WS_SMALL;
    const bf16* Wup_t = (const bf16*)(wl_of(ws, layer) + W_UP);
    pg8::Gemm g{(const bf16*)(ws + WS_XB), Wup_t, MP, DFF, D}; pg8::StaticOrder S; S.init(MP, DFF, G, bx);
    pg8::EpiUp E{(const float*)(ws + WS_SSQ), (bf16*)(ws + WS_F)};
    SEpiUp SE{(const float*)(sm + SM_SSQS), (bf16*)(sm + SM_FS)};
    small_gemm(lds, (const bf16*)(sm + SM_XSB), Wup_t, DFF, D, 0, G, SE);
    pg8::gemm_phase<pg8::EpiUp, pg8::StaticOrder, true, true>(lds, g, S, E);
}

__device__ __forceinline__ void phase6(LAS unsigned char* lds, int layer, bool do_small = true) {
    KARGS(kp); IDS();
    unsigned char* ws = kp->ws; unsigned char* sm = ws + WS_SMALL;
    const bf16* Wdn_t = (const bf16*)(wl_of(ws, layer) + W_DN);
    pg8::Gemm g{(const bf16*)(ws + WS_F), Wdn_t, MP, D, DFF}; pg8::StaticOrder S; S.init(MP, D, G, bx);
    pg8::EpiRes E{(bf16*)(ws + WS_XB), (float*)(ws + WS_SSQ)};
    SEpiRes SE{(float*)(sm + SM_XS), (bf16*)(sm + SM_XSB), (float*)(sm + SM_SSQS)};
    if (do_small) small_gemm(lds, (const bf16*)(sm + SM_FS), Wdn_t, D, DFF, 0, G, SE);
    pg8::gemm_phase<pg8::EpiRes, pg8::StaticOrder, true, true>(lds, g, S, E);
}

__device__ __forceinline__ void phase7() {
    KARGS(kp); IDS();
    unsigned char* ws = kp->ws; unsigned char* sm = ws + WS_SMALL; float* out = kp->out;
    const int gw = bx * 8 + wid, NGW = G * 8;
    const float* SSQ = (const float*)(ws + WS_SSQ); const float* SSQS = (const float*)(sm + SM_SSQS); const float* XS = (const float*)(sm + SM_XS); const bf16* XB = (const bf16*)(ws + WS_XB);
    const f32x4* nf4 = (const f32x4*)kp->in[16];
#pragma unroll 1
    for (int m0 = gw; m0 < MP + SB; m0 += 4 * NGW) {
        f32x4 x[4][4]; float rs[4];
#pragma unroll
        for (int u = 0; u < 4; ++u) { const int m = m0 + u * NGW; const bool smp = m >= MP; const int mr = smp ? m - MP : m;
            if (m < MP + SB) {
                if (smp) rs[u] = SSQS[mr * 64 + lane]; else rs[u] = lane < 16 ? SSQ[(size_t)mr * 16 + lane] : 0.f;
                if (smp) { const f32x4* src = (const f32x4*)(XS + (size_t)mr * D) + lane;
#pragma unroll
                    for (int j = 0; j < 4; ++j) x[u][j] = src[64 * j]; }
                else { const bf16* src = XB + (size_t)mr * D + 4 * lane;
#pragma unroll
                    for (int j = 0; j < 4; ++j) x[u][j] = ld4bf(src + 256 * j); } } }
#pragma unroll
        for (int u = 0; u < 4; ++u) { const int m = m0 + u * NGW; const bool smp = m >= MP; const int mr = smp ? m - MP : m;
            if (m < MP + SB) {
                const float r = rsqrtf(wave_sum(rs[u]) * (1.f / 1024.f) + 1e-6f);
                f32x4* dst = (f32x4*)(smp ? out + O_YS + (size_t)mr * D : out + O_YP + (size_t)mr * D) + lane;
#pragma unroll
                for (int j = 0; j < 4; ++j) { const f32x4 nf = nf4[lane + 64 * j]; __builtin_nontemporal_store(x[u][j] * r * nf, dst + 64 * j); } } }
    }
}

constexpr size_t WS_BAR = 1 * MiB;
constexpr int ST_OFF = LDS_BYTES - 64;
__device__ __forceinline__ void seam(LAS unsigned char* lds) {
    KARGS(kp);
    XcdBarrier b; b.bar = (unsigned*)(kp->ws + WS_BAR); b.x = xb_xcc_id(); b.st = (volatile LAS unsigned*)(lds + ST_OFF);
    xcd_barrier(b);
}
#ifdef PH_ONLY
#define PH_ON(n) (PH_ONLY == (n))
#else
#define PH_ON(n) true
#endif
#ifndef REP_P2
#define REP_P2 1
#endif
#ifndef REP_P6L1
#define REP_P6L1 0
#endif
#ifndef REP_P4L0
#define REP_P4L0 0
#endif
#ifndef XSYNC
#define XSYNC 0
#endif
#ifndef REP_P0
#define REP_P0 1
#endif
#ifndef REP_P1
#define REP_P1 1
#endif
#ifndef REP_P3
#define REP_P3 1
#endif
#ifndef REP_P5
#define REP_P5 1
#endif
__global__ void __launch_bounds__(512, 2) hybrid_fwd(Args args) {
    extern __shared__ __attribute__((aligned(16))) unsigned char lds_raw[];
    LAS unsigned char* lds = (LAS unsigned char*)lds_raw;
    cg::grid_group grid = cg::this_grid();
    {
        KARGS(kp);
        if (threadIdx.x < 2) ((volatile LAS unsigned*)(lds + ST_OFF))[threadIdx.x] = 0u;
        __syncthreads();
        (void)xcd_barrier_post((unsigned*)(kp->ws + WS_BAR), (volatile LAS unsigned*)(lds + ST_OFF));
        if (kp->ws == nullptr) grid.sync();
    }
    for (int rep_ = 0; rep_ < REP_P0; ++rep_) { if (rep_) seam(lds); if (PH_ON(0)) phase0(lds); }
    seam(lds);
#pragma unroll 1
    for (int layer = 0; layer < DEPTH; ++layer) {
#pragma unroll 1
        for (int rep_ = 0; rep_ < REP_P1; ++rep_) { if (rep_) seam(lds); if (PH_ON(1)) phase1(lds, layer); }
        seam(lds);
#pragma unroll 1
        for (int rep_ = 0; rep_ < REP_P2; ++rep_) { if (rep_) seam(lds); if (PH_ON(2)) phase2(lds, layer); }
        seam(lds);
#pragma unroll 1
        for (int rep_ = 0; rep_ < REP_P3; ++rep_) { if (rep_) seam(lds); if (PH_ON(3)) phase3(lds, layer); }
        seam(lds);
        if (PH_ON(4)) phase4(lds, layer);
        seam(lds);
#pragma unroll 1
        for (int r4_ = 0; r4_ < REP_P4L0 && layer == 0; ++r4_) { phase4(lds, layer, false); seam(lds); }
#pragma unroll 1
        for (int rep_ = 0; rep_ < REP_P5; ++rep_) { if (rep_) seam(lds); if (PH_ON(5)) phase5(lds, layer); }
        seam(lds);
        if (PH_ON(6)) phase6(lds, layer);
        seam(lds);
#pragma unroll 1
        for (int r6_ = 0; r6_ < REP_P6L1 && layer == DEPTH - 1; ++r6_) { phase6(lds, layer, false); seam(lds); }
#pragma unroll 1
        for (int xs_ = 0; xs_ < XSYNC; ++xs_) seam(lds);
    }
    if (PH_ON(7)) phase7();
}

extern "C" void kernel_launch(void* const* d_in, const int* in_sizes, int n_in, void* d_out, int out_size, void* d_ws, size_t ws_size, hipStream_t stream) {
    static int grid = 0;
    if (grid == 0) {
        if (n_in != 17 || (size_t)out_size != O_END || ws_size < WS_END) { fprintf(stderr, "kernel_launch: unexpected shapes: n_in %d out %d ws %zu\n", n_in, out_size, ws_size); grid = -1; return; }
        int dev = 0, cus = 0, per_cu = 0;
        (void)hipGetDevice(&dev); (void)hipDeviceGetAttribute(&cus, hipDeviceAttributeMultiprocessorCount, dev);
        if (hipFuncSetAttribute((const void*)hybrid_fwd, hipFuncAttributeMaxDynamicSharedMemorySize, LDS_BYTES) != hipSuccess) { fprintf(stderr, "kernel_launch: hipFuncSetAttribute failed\n"); grid = -1; return; }
        if (hipOccupancyMaxActiveBlocksPerMultiprocessor(&per_cu, (const void*)hybrid_fwd, 512, LDS_BYTES) != hipSuccess || per_cu < 1) { fprintf(stderr, "kernel_launch: occupancy query says %d\n", per_cu); per_cu = 1; }
        (void)hipGetLastError();
        grid = cus;
    }
    if (grid < 0) return;
    if (hipMemsetAsync((char*)d_ws + WS_BAR, 0, XCD_BAR_WORDS * 4, stream) != hipSuccess) { fprintf(stderr, "kernel_launch: hipMemsetAsync failed\n"); return; }
    Args a{};
    for (int i = 0; i < 17; ++i) a.in[i] = (const float*)d_in[i];
    a.out = (float*)d_out; a.ws = (unsigned char*)d_ws;
    for (int i = 0; i < 8; ++i) a.inv[i] = pow(500000.0, -(double)i / 8.0);
    void* kargs[] = {&a};
    const hipError_t e = hipLaunchCooperativeKernel((const void*)hybrid_fwd, dim3(grid), dim3(512), kargs, LDS_BYTES, stream);
    if (e != hipSuccess) fprintf(stderr, "kernel_launch: cooperative launch failed: %s (grid %d)\n", hipGetErrorString(e), grid);
}
```

```cpp
#include <hip/hip_runtime.h>
#include <hip/hip_cooperative_groups.h>
#include <cstdio>
#include <cstdint>
#include <cmath>
namespace cg = cooperative_groups;

namespace cfg {
constexpr int D = 1024, SEQ = 8192, NB = 4, MP = NB * SEQ, DEPTH = 2, SB = 32, PAST = 16384;
constexpr int DIN = 3840, DFF = 4096, CONV = 768, CW = 31;
constexpr float C2 = 0.125f * 1.4426950408889634f;
constexpr size_t O_YP = 0, O_YS = 33554432, O_KP0 = 33587200, O_KP1 = 34111488, O_KP2 = 36208640, O_CP = 44597248,
                 O_KS0 = 44781568, O_KS1 = 48975872, O_KS2 = 65753088, O_CS = 132861952, O_END = 134336512;
}
namespace pg8 {
#define PG8_LAS __attribute__((address_space(3)))
typedef unsigned short bf16_t;
typedef short bf16x8 __attribute__((ext_vector_type(8)));
typedef float f32x4 __attribute__((ext_vector_type(4)));
typedef unsigned u32x4 __attribute__((ext_vector_type(4)));
constexpr int BM = 256, BK = 64, HALF = 128, HTB = HALF * BK * 2  , STAGE_BYTES = 8 * HTB, NXCD = 8, WGM = 8;

__host__ __device__ __forceinline__ int lds_byte(int r, int c) { const int st = (r >> 4) * 2 + (c >> 5), rr = r & 15, cc = c & 31, ob = rr * 64 + cc * 2; return st * 1024 + (ob ^ (((ob >> 9) & 1) << 5)); }
__host__ __device__ __forceinline__ void stage_rc(int b, int& R, int& C) { const int st = b / 1024, sb = b % 1024, swz = sb ^ (((sb >> 9) & 1) << 5); R = (st >> 1) * 16 + swz / 64; C = (st & 1) * 32 + (swz % 64) / 2; }
__host__ __device__ __forceinline__ int perm32(int rho) { const int n = rho >> 4, i = rho & 15; return 8 * (i >> 2) + 4 * n + (i & 3); }

struct Unit { int pm, pn; };
struct Gemm { const bf16_t* A; const bf16_t* Bt; int M, N, K; };

struct StaticOrder {
    int nM, nN, nwg, G, c;
    __host__ __device__ void init(int M, int N, int G_, int c_) { nM = M / BM; nN = N / BM; nwg = nM * nN; G = G_; c = c_; }
    __host__ __device__ bool next(int i, Unit& u) const {
        const long L = (long)i * G + c; if (L >= nwg) return false;
        int wgid = (int)L; { const int q = nwg / NXCD, r = nwg % NXCD, xcd = wgid % NXCD, off = wgid / NXCD; wgid = (xcd < r ? xcd * (q + 1) : r * (q + 1) + (xcd - r) * q) + off; }
        const int nig = WGM * nN, gid = wgid / nig, fm = gid * WGM, gsz = (nM - fm) < WGM ? (nM - fm) : WGM;
        u.pm = fm + ((wgid % nig) % gsz); u.pn = (wgid % nig) / gsz; return true;
    }
    __device__ __forceinline__ void a_ready(const Unit&) const {}
    __device__ __forceinline__ void done(const Unit&) const {}
};

__device__ __forceinline__ unsigned cvt_pk_bf16(float lo, float hi) { unsigned r; asm volatile("v_cvt_pk_bf16_f32 %0, %1, %2" : "=v"(r) : "v"(lo), "v"(hi)); return r; }
typedef float f32x2 __attribute__((ext_vector_type(2)));
typedef unsigned u32x2 __attribute__((ext_vector_type(2)));
__device__ __forceinline__ float row_rs(const float* ssq, int row) {
    const f32x4* sp = (const f32x4*)(ssq + (size_t)row * 16);
    const f32x4 st = (sp[0] + sp[1]) + (sp[2] + sp[3]);
    return rsqrtf(((st[0] + st[1]) + (st[2] + st[3])) * (1.f / 1024.f) + 1e-6f);
}
__device__ __forceinline__ float row_rs4(const float* ssq, int row, int fq) {
    const f32x4 p = *(const f32x4*)(ssq + (size_t)row * 16 + fq * 4);
    float s = (p[0] + p[1]) + (p[2] + p[3]); s += __shfl_xor(s, 16); s += __shfl_xor(s, 32);
    return rsqrtf(s * (1.f / 1024.f) + 1e-6f);
}
struct EpiIn {
    static constexpr bool PERM = true, AFTER_DRAIN = false, HAS_RS = true;
    const float* ssq; const float* cs; bf16_t* Q; size_t kstride; bf16_t* Ub;
    __device__ __forceinline__ void fetch_rs(float (&rsv)[2][4], const Unit& u, int wr, int fr, int fq) const {
#pragma unroll
        for (int ai = 0; ai < 2; ++ai)
#pragma unroll
            for (int m = 0; m < 4; ++m) rsv[ai][m] = row_rs4(ssq, u.pm * BM + wr * 64 + fr + ai * HALF + m * 16, fq);
    }
    __device__ __forceinline__ void operator()(const f32x4 (&acc)[2][2][4][2], const Unit& u, int wr, int wc, int fr, int fq, float (&rsv)[2][4], bool has_next, const Unit& nxt) const {
        const int pn = u.pn;
        const int row0 = u.pm * BM + wr * 64 + fr;
        const int cw = wc * 32 + 8 * fq;
#pragma unroll
        for (int ai = 0; ai < 2; ++ai)
#pragma unroll
            for (int m = 0; m < 4; ++m) {
                const int row = row0 + ai * HALF + m * 16;
                const float rs = rsv[ai][m];
                const int s = row & 8191;
                if (pn < 9) {
                    const int kind = pn / 3, g = pn - kind * 3;
                    bf16_t* dst = Q + (size_t)kind * kstride;
                    const float qs = kind == 0 ? cfg::C2 : 1.f;
                    const bool rot = (kind < 2) && ((wc & 1) == 0);
                    f32x4 cA = {1.f, 1.f, 1.f, 1.f}, cB = cA, sA = {0.f, 0.f, 0.f, 0.f}, sB = sA;
                    if (rot) { const f32x4* cp = (const f32x4*)(cs + (size_t)s * 16); cA = cp[0]; cB = cp[1]; sA = cp[2]; sB = cp[3]; }
#pragma unroll
                    for (int bj = 0; bj < 2; ++bj) {
                        f32x4 v0 = acc[ai][bj][m][0] * rs, v1 = acc[ai][bj][m][1] * rs;
                        if (rot) {
                            f32x4 o0, o1;
#pragma unroll
                            for (int i = 0; i < 4; ++i) { o0[i] = __shfl_xor(v0[i], 16); o1[i] = __shfl_xor(v1[i], 16); }
                            if (fq < 2) { const float sg = fq == 0 ? -1.f : 1.f; v0 = v0 * cA + (o0 * sA) * sg; v1 = v1 * cB + (o1 * sB) * sg; }
                        }
                        const int col = g * 256 + bj * HALF + cw;
                        v0 = v0 * qs; v1 = v1 * qs;
                        u32x4 w; w.x = cvt_pk_bf16(v0[0], v0[1]); w.y = cvt_pk_bf16(v0[2], v0[3]); w.z = cvt_pk_bf16(v1[0], v1[1]); w.w = cvt_pk_bf16(v1[2], v1[3]);
                        *(u32x4*)(dst + (size_t)row * 768 + col) = w;
                    }
                } else {
                    const int ch = (pn - 9) * 128 + cw;
                    const f32x4 a0 = acc[ai][0][m][0] * rs, a1 = acc[ai][0][m][1] * rs, g0 = acc[ai][1][m][0] * rs, g1 = acc[ai][1][m][1] * rs;
                    f32x4 u0, u1;
#pragma unroll
                    for (int i = 0; i < 4; ++i) { u0[i] = a0[i] * __builtin_amdgcn_rcpf(1.f + __expf(-g0[i])); u1[i] = a1[i] * __builtin_amdgcn_rcpf(1.f + __expf(-g1[i])); }
                    u32x4 w; w.x = cvt_pk_bf16(u0[0], u0[1]); w.y = cvt_pk_bf16(u0[2], u0[3]); w.z = cvt_pk_bf16(u1[0], u1[1]); w.w = cvt_pk_bf16(u1[2], u1[3]);
                    *(u32x4*)(Ub + (size_t)row * 768 + ch) = w;
                }
            }
        if (has_next) fetch_rs(rsv, nxt, wr, fr, fq);
    }
};
struct EpiRes {
    static constexpr bool PERM = true, AFTER_DRAIN = false, HAS_RS = false;
    bf16_t* xb; float* ssq;
    __device__ __forceinline__ void operator()(const f32x4 (&acc)[2][2][4][2], const Unit& u, int wr, int wc, int fr, int fq) const {
        const int row0 = u.pm * BM + wr * 64 + fr, col0 = u.pn * BM + wc * 32 + 8 * fq;
#pragma unroll
        for (int ai = 0; ai < 2; ++ai) {
            u32x4 bw[4][2];
#pragma unroll
            for (int m = 0; m < 4; ++m)
#pragma unroll
                for (int bj = 0; bj < 2; ++bj) bw[m][bj] = *(const u32x4*)(xb + (size_t)(row0 + ai * HALF + m * 16) * 1024 + col0 + bj * HALF);
#pragma unroll
            for (int m = 0; m < 4; ++m) {
                const int row = row0 + ai * HALF + m * 16; const size_t off = (size_t)row * 1024 + col0; float q = 0.f;
#pragma unroll
                for (int bj = 0; bj < 2; ++bj) {
                    const u32x4 b4 = bw[m][bj];
                    f32x4 o0 = acc[ai][bj][m][0], o1 = acc[ai][bj][m][1];
                    o0[0] += __uint_as_float(b4.x << 16); o0[1] += __uint_as_float(b4.x & 0xffff0000u); o0[2] += __uint_as_float(b4.y << 16); o0[3] += __uint_as_float(b4.y & 0xffff0000u);
                    o1[0] += __uint_as_float(b4.z << 16); o1[1] += __uint_as_float(b4.z & 0xffff0000u); o1[2] += __uint_as_float(b4.w << 16); o1[3] += __uint_as_float(b4.w & 0xffff0000u);
                    { u32x4 w; w.x = cvt_pk_bf16(o0[0], o0[1]); w.y = cvt_pk_bf16(o0[2], o0[3]); w.z = cvt_pk_bf16(o1[0], o1[1]); w.w = cvt_pk_bf16(o1[2], o1[3]); *(u32x4*)(xb + off + bj * HALF) = w; }
                    q += ((o0[0] * o0[0] + o0[1] * o0[1]) + (o0[2] * o0[2] + o0[3] * o0[3])) + ((o1[0] * o1[0] + o1[1] * o1[1]) + (o1[2] * o1[2] + o1[3] * o1[3]));
                }
                q += __shfl_xor(q, 16); q += __shfl_xor(q, 32);
                if (fq == 0) ssq[(size_t)row * 16 + u.pn * 4 + wc] = q;
            }
        }
    }
};
struct EpiUp {
    static constexpr bool PERM = true, AFTER_DRAIN = false, HAS_RS = true;
    const float* ssq; bf16_t* F;
    __device__ __forceinline__ void fetch_rs(float (&rsv)[2][4], const Unit& u, int wr, int fr, int fq) const {
#pragma unroll
        for (int ai = 0; ai < 2; ++ai)
#pragma unroll
            for (int m = 0; m < 4; ++m) rsv[ai][m] = row_rs4(ssq, u.pm * BM + wr * 64 + fr + ai * HALF + m * 16, fq);
    }
    __device__ __forceinline__ void operator()(const f32x4 (&acc)[2][2][4][2], const Unit& u, int wr, int wc, int fr, int fq, float (&rsv)[2][4], bool has_next, const Unit& nxt) const {
        const int row0 = u.pm * BM + wr * 64 + fr, col0 = u.pn * BM + wc * 32 + 8 * fq;
#pragma unroll
        for (int ai = 0; ai < 2; ++ai)
#pragma unroll
            for (int m = 0; m < 4; ++m) {
                const int row = row0 + ai * HALF + m * 16; const float rs = rsv[ai][m];
#pragma unroll
                for (int bj = 0; bj < 2; ++bj) {
                    f32x4 v0 = acc[ai][bj][m][0] * rs, v1 = acc[ai][bj][m][1] * rs;
#pragma unroll
                    for (int i = 0; i < 4; ++i) { const float a = fmaxf(v0[i], 0.f), c = fmaxf(v1[i], 0.f); v0[i] = a * a; v1[i] = c * c; }
                    u32x4 w; w.x = cvt_pk_bf16(v0[0], v0[1]); w.y = cvt_pk_bf16(v0[2], v0[3]); w.z = cvt_pk_bf16(v1[0], v1[1]); w.w = cvt_pk_bf16(v1[2], v1[3]);
                    *(u32x4*)(F + (size_t)row * 4096 + col0 + bj * HALF) = w;
                }
            }
        if (has_next) fetch_rs(rsv, nxt, wr, fr, fq);
    }
};

template <class Epi, class Sched, bool ALIGN_EPI = false, bool SP2 = false>
__device__ __forceinline__ void gemm_phase(PG8_LAS unsigned char* lds, const Gemm g, const Sched& S, const Epi& E) {
    int tid_ = threadIdx.x; asm volatile("" : "+v"(tid_));
    const int tid = tid_, wid = __builtin_amdgcn_readfirstlane(tid >> 6), lane = tid & 63, wr = wid >> 2, wc = wid & 3, fr = lane & 15, fq = lane >> 4;
    const int K = g.K, nt = K / BK;
    unsigned voffA[2], voffB[2];
#pragma unroll
    for (int i = 0; i < 2; ++i) { int R, C; stage_rc(tid * 16 + i * 8192, R, C); const int Rb = Epi::PERM ? ((R & ~31) + perm32(R & 31)) : R;
        voffA[i] = (unsigned)(R * K + C) * 2u; voffB[i] = (unsigned)(Rb * K + C) * 2u; }
    const size_t kstep = (size_t)(BK * 2);
    const size_t hstep = (size_t)HALF * K * 2;
    const size_t tstep = 2 * hstep;
    const unsigned ldsw = (unsigned)wid * 1024u;
    const int aoff = lds_byte(wr * 64 + fr, fq * 8), boff = lds_byte(wc * 32 + fr, fq * 8);
#define PG8_SA(b, h) (((b) * 2 + (h)) * HTB)
#define PG8_SB(b, h) ((4 + (b) * 2 + (h)) * HTB)
#define PG8_STAGE(bufoff, gbase, voff) do { _Pragma("unroll") for (int _i = 0; _i < 2; ++_i) \
        __builtin_amdgcn_global_load_lds((const unsigned*)((const char*)(gbase) + (voff)[_i]), (PG8_LAS unsigned*)(lds + (bufoff) + ldsw + _i * 8192), 16, 0, 0); } while (0)
#define PG8_LDA(dst, b, h) do { _Pragma("unroll") for (int m = 0; m < 4; ++m) _Pragma("unroll") for (int k = 0; k < 2; ++k) dst[m][k] = *(const PG8_LAS bf16x8*)(lds + PG8_SA(b, h) + aoff + m * 2048 + k * 1024); } while (0)
#define PG8_LDB(dst, b, h) do { _Pragma("unroll") for (int n = 0; n < 2; ++n) _Pragma("unroll") for (int k = 0; k < 2; ++k) dst[n][k] = *(const PG8_LAS bf16x8*)(lds + PG8_SB(b, h) + boff + n * 2048 + k * 1024); } while (0)
#define PG8_MMA(ai, bj, At, Bt) do { __builtin_amdgcn_s_setprio(1); _Pragma("unroll") for (int m = 0; m < 4; ++m) _Pragma("unroll") for (int n = 0; n < 2; ++n) _Pragma("unroll") for (int k = 0; k < 2; ++k) \
        acc[ai][bj][m][n] = __builtin_amdgcn_mfma_f32_16x16x32_bf16(Bt[n][k], At[m][k], acc[ai][bj][m][n], 0, 0, 0); __builtin_amdgcn_s_setprio(0); } while (0)
#define PG8_WAIT_V(n) asm volatile("s_waitcnt vmcnt(" #n ")" ::: "memory")
#define PG8_WAIT_L(n) asm volatile("s_waitcnt lgkmcnt(" #n ")" ::: "memory")
#define PG8_BAR __builtin_amdgcn_s_barrier()
#define PG8_SCHED __builtin_amdgcn_sched_barrier(0)
    Unit cur, nxt; int ui = 0;
    if (!S.next(0, cur)) return;
    f32x4 acc[2][2][4][2];
    float rsv[2][4];
    if constexpr (Epi::HAS_RS) E.fetch_rs(rsv, cur, wr, fr, fq);
#pragma unroll
    for (int a = 0; a < 2; ++a)
#pragma unroll
        for (int b = 0; b < 2; ++b)
#pragma unroll
            for (int m = 0; m < 4; ++m)
#pragma unroll
                for (int n = 0; n < 2; ++n) acc[a][b][m][n] = (f32x4){0.f, 0.f, 0.f, 0.f};
    bf16x8 At[4][2], B0[2][2], B1[2][2];
    const char* cA = (const char*)g.A + (size_t)cur.pm * tstep; const char* cB = (const char*)g.Bt + (size_t)cur.pn * tstep;
    S.a_ready(cur);
    if constexpr (SP2) {
        PG8_STAGE(PG8_SB(0, 0), cB, voffB); PG8_STAGE(PG8_SB(0, 1), cB + hstep, voffB); PG8_STAGE(PG8_SA(0, 0), cA, voffA); PG8_STAGE(PG8_SA(0, 1), cA + hstep, voffA);
        if (wr == 1) PG8_BAR;
        PG8_WAIT_V(2); PG8_BAR;
        PG8_STAGE(PG8_SB(1, 0), cB + kstep, voffB); PG8_STAGE(PG8_SA(1, 0), cA + kstep, voffA); PG8_STAGE(PG8_SB(1, 1), cB + hstep + kstep, voffB);
        PG8_WAIT_V(6); PG8_BAR;
    } else {
        PG8_STAGE(PG8_SB(0, 0), cB, voffB); PG8_STAGE(PG8_SA(0, 0), cA, voffA); PG8_STAGE(PG8_SB(0, 1), cB + hstep, voffB); PG8_STAGE(PG8_SA(0, 1), cA + hstep, voffA);
        if (wr == 1) PG8_BAR;
        PG8_WAIT_V(4); PG8_BAR;
        PG8_STAGE(PG8_SB(1, 0), cB + kstep, voffB); PG8_STAGE(PG8_SA(1, 0), cA + kstep, voffA); PG8_STAGE(PG8_SB(1, 1), cB + hstep + kstep, voffB);
        PG8_WAIT_V(6); PG8_BAR;
    }
    for (;;) {
        const bool has_next = S.next(ui + 1, nxt);
        const char* nA = has_next ? (const char*)g.A + (size_t)nxt.pm * tstep : cA; const char* nB = has_next ? (const char*)g.Bt + (size_t)nxt.pn * tstep : cB;
        for (int t = 0; t < nt; t += 2) {
            const bool last = (t == nt - 2);
            const char* a1 = cA + (size_t)(t + 1) * kstep;
            const char* a2 = last ? nA : cA + (size_t)(t + 2) * kstep; const char* b2 = last ? nB : cB + (size_t)(t + 2) * kstep;
            const char* a3 = a2 + kstep; const char* b3 = b2 + kstep;
            if (last && has_next) S.a_ready(nxt);
            if constexpr (SP2) {
            PG8_LDB(B0, 0, 0); PG8_LDB(B1, 0, 1); PG8_SCHED; PG8_LDA(At, 0, 0); PG8_STAGE(PG8_SA(1, 1), a1 + hstep, voffA);
            PG8_WAIT_V(8); PG8_WAIT_L(0); PG8_BAR; PG8_MMA(0, 0, At, B0); PG8_MMA(0, 1, At, B1); PG8_BAR; PG8_SCHED;
            PG8_LDA(At, 0, 1); PG8_STAGE(PG8_SB(0, 0), b2, voffB); PG8_STAGE(PG8_SB(0, 1), b2 + hstep, voffB); PG8_STAGE(PG8_SA(0, 0), a2, voffA);
            PG8_WAIT_V(8); PG8_WAIT_L(0); PG8_BAR; PG8_MMA(1, 0, At, B0); PG8_MMA(1, 1, At, B1); PG8_BAR; PG8_SCHED;
            PG8_LDB(B0, 1, 0); PG8_LDB(B1, 1, 1); PG8_SCHED; PG8_LDA(At, 1, 0); PG8_STAGE(PG8_SA(0, 1), a2 + hstep, voffA);
            PG8_WAIT_V(8); PG8_WAIT_L(0); PG8_BAR; PG8_MMA(0, 0, At, B0); PG8_MMA(0, 1, At, B1); PG8_BAR; PG8_SCHED;
            PG8_LDA(At, 1, 1); PG8_STAGE(PG8_SB(1, 0), b3, voffB); PG8_STAGE(PG8_SB(1, 1), b3 + hstep, voffB); PG8_STAGE(PG8_SA(1, 0), a3, voffA);
            PG8_WAIT_V(8); PG8_WAIT_L(0); PG8_BAR; PG8_MMA(1, 0, At, B0); PG8_MMA(1, 1, At, B1); PG8_BAR; PG8_SCHED;
            } else {
            PG8_LDB(B0, 0, 0); PG8_SCHED; PG8_LDA(At, 0, 0); PG8_STAGE(PG8_SA(1, 1), a1 + hstep, voffA);
            PG8_WAIT_L(8); PG8_BAR; PG8_WAIT_L(0); PG8_MMA(0, 0, At, B0); PG8_BAR; PG8_SCHED;
            PG8_LDB(B1, 0, 1); PG8_STAGE(PG8_SB(0, 0), b2, voffB);
            PG8_BAR; PG8_WAIT_L(0); PG8_MMA(0, 1, At, B1); PG8_BAR;
            PG8_LDA(At, 0, 1); PG8_STAGE(PG8_SA(0, 0), a2, voffA);
            PG8_BAR; PG8_WAIT_L(0); PG8_MMA(1, 0, At, B0); PG8_BAR; PG8_SCHED;
            PG8_STAGE(PG8_SB(0, 1), b2 + hstep, voffB);
            PG8_WAIT_V(6); PG8_BAR; PG8_MMA(1, 1, At, B1); PG8_BAR;
            PG8_LDB(B0, 1, 0); PG8_SCHED; PG8_LDA(At, 1, 0); PG8_STAGE(PG8_SA(0, 1), a2 + hstep, voffA);
            PG8_WAIT_L(8); PG8_BAR; PG8_WAIT_L(0); PG8_MMA(0, 0, At, B0); PG8_BAR; PG8_SCHED;
            PG8_LDB(B1, 1, 1); PG8_STAGE(PG8_SB(1, 0), b3, voffB);
            PG8_BAR; PG8_WAIT_L(0); PG8_MMA(0, 1, At, B1); PG8_BAR;
            PG8_LDA(At, 1, 1); PG8_STAGE(PG8_SA(1, 0), a3, voffA);
            PG8_BAR; PG8_WAIT_L(0); PG8_MMA(1, 0, At, B0); PG8_BAR; PG8_SCHED;
            PG8_STAGE(PG8_SB(1, 1), b3 + hstep, voffB);
            PG8_WAIT_V(6); PG8_BAR; PG8_MMA(1, 1, At, B1); PG8_BAR;
            }
        }
        if constexpr (ALIGN_EPI) { if (wr == 0) PG8_BAR; }
        if constexpr (Epi::HAS_RS) { E(acc, cur, wr, wc, fr, fq, rsv, has_next, nxt); S.done(cur); }
        else if constexpr (!Epi::AFTER_DRAIN) { E(acc, cur, wr, wc, fr, fq); S.done(cur); }
        if (!has_next) break;
#pragma unroll
        for (int a = 0; a < 2; ++a)
#pragma unroll
            for (int b = 0; b < 2; ++b)
#pragma unroll
                for (int m = 0; m < 4; ++m)
#pragma unroll
                    for (int n = 0; n < 2; ++n) acc[a][b][m][n] = (f32x4){0.f, 0.f, 0.f, 0.f};
        cur = nxt; cA = nA; cB = nB; ++ui;
        if constexpr (ALIGN_EPI) { if (wr == 1) PG8_BAR; }
    }
    PG8_WAIT_V(0);
    if constexpr (!ALIGN_EPI) { if (wr == 0) PG8_BAR; }
    PG8_BAR;
    if constexpr (Epi::AFTER_DRAIN) { E.fused(acc, cur, wr, wc, fr, fq, lds, wid, lane); S.done(cur); }
#undef PG8_SA
#undef PG8_SB
#undef PG8_STAGE
#undef PG8_LDA
#undef PG8_LDB
#undef PG8_MMA
#undef PG8_WAIT_V
#undef PG8_WAIT_L
#undef PG8_BAR
#undef PG8_SCHED
}
}

#define LAS __attribute__((address_space(3)))
typedef unsigned short bf16;
typedef float f32x4 __attribute__((ext_vector_type(4)));
typedef float f32x16 __attribute__((ext_vector_type(16)));
typedef short bf16x8 __attribute__((ext_vector_type(8)));
typedef short s16x4 __attribute__((ext_vector_type(4)));
typedef unsigned u32x4 __attribute__((ext_vector_type(4)));
typedef unsigned u32x2 __attribute__((ext_vector_type(2)));
using namespace cfg;
constexpr size_t MiB = 1u << 20;
constexpr size_t WS_W = 2 * MiB, W_LSTRIDE = 26 * MiB, W_IN = 0, W_O = 8 * MiB, W_UP = 10 * MiB, W_DN = 18 * MiB;
constexpr size_t WS_CS = 54 * MiB, WS_SSQ = 55 * MiB, WS_LSE = 57 * MiB, WS_SMALL = 59 * MiB;
constexpr size_t WS_XB = 64 * MiB, WS_R = 128 * MiB, WS_Q = 256 * MiB, WS_K = 304 * MiB, WS_V = 352 * MiB, WS_U = 400 * MiB, WS_CAT = 448 * MiB, WS_F = 256 * MiB, WS_OG = 512 * MiB, WS_END = 560 * MiB;
constexpr size_t SM_XS = 0, SM_XSB = 131072, SM_ZS = 196608, SM_SSQS = 688128, SM_OGS = 696320, SM_LSES = 794624, SM_CATS = 798720, SM_FS = 864256, SM_CVS = 1126400, SM_END = 1224704;
constexpr int LDS_BYTES = 163840;

#define WS_DPP(v, ctrl) __uint_as_float((unsigned)__builtin_amdgcn_update_dpp(0, (int)__float_as_uint(v), (ctrl), 0xf, 0xf, true))
__device__ __forceinline__ float wave_sum(float v) {
    v += WS_DPP(v, 0xB1);
    v += WS_DPP(v, 0x4E);
    v += WS_DPP(v, 0x141);
    v += WS_DPP(v, 0x140);
    v += __shfl_xor(v, 16);
    const auto rr = __builtin_amdgcn_permlane32_swap(__float_as_uint(v), __float_as_uint(v), false, false);
    return __uint_as_float(rr[0]) + __uint_as_float(rr[1]);
}
__device__ __forceinline__ float wave_max(float v) {
#pragma unroll
    for (int o = 1; o < 64; o <<= 1) v = fmaxf(v, __shfl_xor(v, o));
    return v;
}
__device__ __forceinline__ unsigned pk2(float lo, float hi) { return pg8::cvt_pk_bf16(lo, hi); }
__device__ __forceinline__ float bflo(unsigned x) { return __uint_as_float(x << 16); }
__device__ __forceinline__ float bfhi(unsigned x) { return __uint_as_float(x & 0xffff0000u); }
__device__ __forceinline__ f32x4 ld4bf(const bf16* p) { const u32x2 w = *(const u32x2*)p; return (f32x4){bflo(w.x), bfhi(w.x), bflo(w.y), bfhi(w.y)}; }
__device__ __forceinline__ void st4bf(bf16* p, f32x4 v) { u32x2 w; w.x = pk2(v[0], v[1]); w.y = pk2(v[2], v[3]); *(u32x2*)p = w; }

__device__ __forceinline__ void p0_transpose_item(const float* W, int K, int N, int srccol0, const float* gain, bf16* WT, int drow0, LAS float* scr, int k0, int lane) {
    f32x4 wv[8];
#pragma unroll
    for (int i = 0; i < 8; ++i) { const int kk = 8 * i + (lane >> 3); wv[i] = __builtin_nontemporal_load((const f32x4*)(W + (size_t)(k0 + kk) * N + srccol0 + 4 * (lane & 7))); if (gain) wv[i] = wv[i] * gain[k0 + kk]; }
#pragma unroll
    for (int i = 0; i < 8; ++i) { const int kk = 8 * i + (lane >> 3); LAS float* d = scr + kk * 33 + 4 * (lane & 7); d[0] = wv[i][0]; d[1] = wv[i][1]; d[2] = wv[i][2]; d[3] = wv[i][3]; }
    asm volatile("s_waitcnt lgkmcnt(0)" ::: "memory");
    const int c = lane & 7;
#pragma unroll
    for (int j = 0; j < 4; ++j) { const int n = (lane >> 3) + 8 * j; const LAS float* s = scr + (8 * c) * 33 + n;
        u32x4 o; o.x = pk2(s[0 * 33], s[1 * 33]); o.y = pk2(s[2 * 33], s[3 * 33]); o.z = pk2(s[4 * 33], s[5 * 33]); o.w = pk2(s[6 * 33], s[7 * 33]);
        *(u32x4*)(WT + (size_t)(drow0 + n) * K + k0 + 8 * c) = o; }
    asm volatile("s_waitcnt lgkmcnt(0)" ::: "memory");
}
__device__ __forceinline__ int win_srccol(int n) {
    if (n < 2304) return n;
    const int t = (n - 2304) >> 8, w = (n - 2304) & 255;
    return w < 128 ? 2304 + 128 * t + w : 3072 + 128 * t + (w - 128);
}
constexpr int NCHUNK = 43008, CH_P2 = 0, CH_P3 = 24576, CH_P0 = 40960, P1_CHUNKS = 8192;
#define CPY_LOAD(V, OKM, CH, in0, in1, in2) { const int c_ = (CH); const int g_ = c_ < 2048 ? 0 : (c_ < 10240 ? 1 : 2); const int n_ = 128 << (2 * g_); \
    const size_t li_ = (size_t)c_ * 512 - (g_ == 0 ? (size_t)0 : (g_ == 1 ? (size_t)1048576 : (size_t)5242880)); \
    const f32x4* s4_ = (const f32x4*)(g_ == 0 ? (in0) : (g_ == 1 ? (in1) : (in2))) + li_ + 64 + lane; OKM = 0u; \
    _Pragma("unroll") for (int u = 0; u < 8; ++u) { const unsigned row_ = (unsigned)((li_ >> 6) + u) & (unsigned)(n_ - 1); \
        if (row_ < (unsigned)(n_ - 1)) { V[u] = __builtin_nontemporal_load(s4_ + u * 64); OKM |= 1u << u; } } }
#define CPY_STORE(V, OKM, CH, outp) { f32x4* d4_ = (f32x4*)((outp) + O_KS0) + (size_t)(CH) * 512 + lane; \
    _Pragma("unroll") for (int u = 0; u < 8; ++u) if ((OKM >> u) & 1u) __builtin_nontemporal_store(V[u], d4_ + u * 64); }

template <class Epi>
__device__ __forceinline__ void small_gemm(LAS unsigned char* lds, const bf16* A, const bf16* Bt, int N, int K, int first_blk, int n_blk, const Epi& E) {
    int tid_ = threadIdx.x; asm volatile("" : "+v"(tid_));
    const int tid = tid_, lane = tid & 63, wid = __builtin_amdgcn_readfirstlane(tid >> 6);
    int bidx = (int)blockIdx.x; asm volatile("" : "+s"(bidx));
    LAS f32x4* red = (LAS f32x4*)lds;
    const int kw = K >> 3;
    if (bidx < first_blk || bidx >= first_blk + n_blk) return;
    for (int unit = bidx - first_blk; unit < (N >> 4); unit += n_blk) {
        const int n0 = unit * 16;
        f32x4 acc0 = {0.f, 0.f, 0.f, 0.f}, acc1 = acc0;
        const bf16* ap = A + (size_t)(lane & 15) * K + wid * kw + 8 * (lane >> 4);
        const bf16* bp = Bt + (size_t)(n0 + (lane & 15)) * K + wid * kw + 8 * (lane >> 4);
        for (int k = 0; k < kw; k += 128) {
            bf16x8 a0[4], a1[4], b[4];
#pragma unroll
            for (int j = 0; j < 4; ++j) { a0[j] = *(const bf16x8*)(ap + k + 32 * j); a1[j] = *(const bf16x8*)(ap + (size_t)16 * K + k + 32 * j); b[j] = *(const bf16x8*)(bp + k + 32 * j); }
#pragma unroll
            for (int j = 0; j < 4; ++j) { acc0 = __builtin_amdgcn_mfma_f32_16x16x32_bf16(a0[j], b[j], acc0, 0, 0, 0); acc1 = __builtin_amdgcn_mfma_f32_16x16x32_bf16(a1[j], b[j], acc1, 0, 0, 0); }
        }
        red[(wid * 2 + 0) * 64 + lane] = acc0; red[(wid * 2 + 1) * 64 + lane] = acc1;
        __syncthreads();
        const int row = tid >> 4, col = tid & 15, t = row >> 4, rr = row & 15, sl = (rr >> 2) * 16 + col, rg = rr & 3;
        float v = 0.f;
#pragma unroll
        for (int w = 0; w < 8; ++w) v += ((LAS float*)(red + (w * 2 + t) * 64 + sl))[rg];
        E(row, col, unit, v);
        __syncthreads();
    }
}
__device__ __forceinline__ float sum16(float v) { v += __shfl_xor(v, 1); v += __shfl_xor(v, 2); v += __shfl_xor(v, 4); v += __shfl_xor(v, 8); return v; }
__device__ __forceinline__ float srow_rs(const float* ssqs, int row, int col) {
    const f32x4 p = *(const f32x4*)(ssqs + row * 64 + col * 4);
    return rsqrtf(sum16((p[0] + p[1]) + (p[2] + p[3])) * (1.f / 1024.f) + 1e-6f);
}
struct SEpiIn { const float* ssqs; float* zs;
    __device__ __forceinline__ void operator()(int row, int col, int unit, float v) const { const float rs = srow_rs(ssqs, row, col); zs[row * DIN + unit * 16 + col] = v * rs; } };
struct SEpiRes { float* xs; bf16* xsb; float* ssqs;
    __device__ __forceinline__ void operator()(int row, int col, int unit, float v) const {
        const int c = unit * 16 + col; const float h = xs[row * 1024 + c] + v; xs[row * 1024 + c] = h;
        const unsigned hb = pk2(h, 0.f); xsb[row * 1024 + c] = (bf16)(hb & 0xffffu);
        const float q = sum16(h * h); if (col == 0) ssqs[row * 64 + unit] = q; } };
struct SEpiUp { const float* ssqs; bf16* fs;
    __device__ __forceinline__ void operator()(int row, int col, int unit, float v) const { const float rs = srow_rs(ssqs, row, col); const float a = fmaxf(v * rs, 0.f);
        const unsigned hb = pk2(a * a, 0.f); fs[row * DFF + unit * 16 + col] = (bf16)(hb & 0xffffu); } };

__device__ __forceinline__ int crow(int r, int hi) { return (r & 3) + 8 * (r >> 2) + 4 * hi; }
__device__ __forceinline__ s16x4 vtr(const LAS unsigned char* p) { typedef short v4i16_t __attribute__((ext_vector_type(4))); return __builtin_bit_cast(s16x4, __builtin_amdgcn_ds_read_tr16_b64_v4i16((LAS v4i16_t*)p)); }
constexpr int VSTR = 192;
constexpr int AK_PITCH = 144, AV_PITCH = 192, AK_BYTES = 384 * AK_PITCH, AV_BYTES = 384 * AV_PITCH;
static_assert(AK_BYTES + AV_BYTES <= LDS_BYTES - 64, "attention LDS map");
struct AttRound { int b, gh, dil, r, c0; };
__device__ __forceinline__ AttRound att_round(int R) {
    AttRound a; const int it = R * 8, cidx = it & 255, bg = it >> 8; a.b = bg / 12; a.gh = bg - a.b * 12; const int g = a.gh >> 2; a.dil = 1 << (2 * g); const int per = 256 >> (2 * g);
    a.r = cidx / per; a.c0 = cidx % per; return a;
}
#define ATT_STAGE_LOAD(PC, QN, A) { const int kb0_ = 32 * (A).c0 - 128; const size_t rs_ = (size_t)(A).dil * 768; \
        const size_t e0_ = ((size_t)(A).b * SEQ + (A).r) * 768 + (A).gh * 64 + (tid & 7) * 8; \
        _Pragma("unroll") for (int j = 0; j < 12; ++j) { const int slot = (tid >> 3) + 64 * (j % 6); PC[j] = (u32x4){0u, 0u, 0u, 0u}; \
            if (kb0_ + slot >= 0) PC[j] = *(const u32x4*)((j < 6 ? Kb : Vb) + e0_ + (size_t)(kb0_ + slot) * rs_); } \
        const bf16* qp_ = Qb + ((size_t)(A).b * SEQ + (size_t)(32 * ((A).c0 + wid) + r32) * (A).dil + (A).r) * 768 + (A).gh * 64 + hi * 8; \
        _Pragma("unroll") for (int d0 = 0; d0 < 4; ++d0) QN[d0] = *(const bf16x8*)(qp_ + d0 * 16); }
#define ATT_STAGE_STORE(PC) { _Pragma("unroll") for (int j = 0; j < 12; ++j) { const int slot = (tid >> 3) + 64 * (j % 6); \
        *(LAS u32x4*)(lds + (j < 6 ? slot * AK_PITCH : AK_BYTES + slot * AV_PITCH) + (tid & 7) * 16) = PC[j]; } }
__device__ __forceinline__ void attn_compute(const LAS unsigned char* lds, const bf16x8 (&qr)[4], bf16* OG, float* LSE, const AttRound& A, int wid, int lane) {
    const int r32 = lane & 31, hi = lane >> 5, i0 = 32 * (A.c0 + wid);
    const size_t rowq = (size_t)A.b * SEQ + (size_t)(i0 + r32) * A.dil + A.r;
    const float NEG = -1e30f;
    float mx = NEG, l = 0.f;
    f32x16 o[2];
#pragma unroll
    for (int g = 0; g < 16; ++g) { o[0][g] = 0.f; o[1][g] = 0.f; }
    const LAS unsigned char* kfb = lds + (32 * wid + r32) * AK_PITCH + hi * 16;
    const LAS unsigned char* trb = lds + AK_BYTES + (32 * wid + 4 * hi + ((lane & 15) >> 2)) * AV_PITCH + ((lane >> 4) & 1) * 32 + (lane & 3) * 8;
#pragma unroll 1
    for (int t = (i0 >= 128 ? 0 : 4 - (i0 >> 5)); t < 5; ++t) {
        f32x16 s = {0.f, 0.f, 0.f, 0.f, 0.f, 0.f, 0.f, 0.f, 0.f, 0.f, 0.f, 0.f, 0.f, 0.f, 0.f, 0.f};
#pragma unroll
        for (int d0 = 0; d0 < 4; ++d0) { const bf16x8 kf = *(const LAS bf16x8*)(kfb + (32 * t) * AK_PITCH + d0 * 32); s = __builtin_amdgcn_mfma_f32_32x32x16_bf16(kf, qr[d0], s, 0, 0, 0); }
        if (t == 0) {
#pragma unroll
            for (int g = 0; g < 16; ++g) if (crow(g, hi) < r32) s[g] = NEG;
        }
        if (t == 4) {
#pragma unroll
            for (int g = 0; g < 16; ++g) if (crow(g, hi) > r32) s[g] = NEG;
        }
        float tm = s[0];
#pragma unroll
        for (int g = 1; g < 16; ++g) tm = fmaxf(tm, s[g]);
        { const auto rr = __builtin_amdgcn_permlane32_swap(__float_as_uint(tm), __float_as_uint(tm), false, false); tm = fmaxf(__uint_as_float(rr[0]), __uint_as_float(rr[1])); }
        const float mn = fmaxf(mx, tm), alpha = __builtin_amdgcn_exp2f(mx - mn);
        mx = mn;
        float ps = 0.f;
#pragma unroll
        for (int g = 0; g < 16; ++g) { const float p = __builtin_amdgcn_exp2f(s[g] - mn); s[g] = p; ps += p; }
        l = l * alpha + ps;
#pragma unroll
        for (int g = 0; g < 16; ++g) { o[0][g] *= alpha; o[1][g] *= alpha; }
        const LAS unsigned char* vt = trb + (32 * t) * AV_PITCH;
#pragma unroll
        for (int sx = 0; sx < 2; ++sx) {
            u32x4 pw; pw.x = pk2(s[8 * sx + 0], s[8 * sx + 1]); pw.y = pk2(s[8 * sx + 2], s[8 * sx + 3]); pw.z = pk2(s[8 * sx + 4], s[8 * sx + 5]); pw.w = pk2(s[8 * sx + 6], s[8 * sx + 7]);
            const bf16x8 pf = __builtin_bit_cast(bf16x8, pw);
#pragma unroll
            for (int d0 = 0; d0 < 2; ++d0) {
                const s16x4 lo = vtr(vt + (16 * sx) * AV_PITCH + d0 * 64), hh = vtr(vt + (16 * sx + 8) * AV_PITCH + d0 * 64);
                const bf16x8 vf = {lo[0], lo[1], lo[2], lo[3], hh[0], hh[1], hh[2], hh[3]};
                o[d0] = __builtin_amdgcn_mfma_f32_32x32x16_bf16(vf, pf, o[d0], 0, 0, 0);
            }
        }
    }
    { const auto rr = __builtin_amdgcn_permlane32_swap(__float_as_uint(l), __float_as_uint(l), false, false); l = __uint_as_float(rr[0]) + __uint_as_float(rr[1]); }
    const float rl = 1.f / l;
    bf16* op = OG + rowq * 768 + A.gh * 64;
#pragma unroll
    for (int d0 = 0; d0 < 2; ++d0)
#pragma unroll
        for (int a = 0; a < 4; ++a) {
            const f32x4 v = {o[d0][4 * a] * rl, o[d0][4 * a + 1] * rl, o[d0][4 * a + 2] * rl, o[d0][4 * a + 3] * rl};
            st4bf(op + 32 * d0 + 8 * a + 4 * hi, v);
        }
    if (hi == 0) LSE[rowq * 12 + A.gh] = mx + __builtin_amdgcn_logf(l);
}
__device__ __forceinline__ void sattn_block(LAS unsigned char* lds, const float* zs, const float* cs, const float* cache, float* outkv, float* ogs, float* lses, int layer, int b, int h, int g, int lane, int wid) {
    const int n = 128 << (2 * g), dil = 1 << (2 * g);
    LAS float* sh = (LAS float*)lds;
    LAS float* qs = sh + 1024 + wid * 128;
    const float* zr = zs + b * DIN + g * 256 + h * 64 + lane;
    float q = zr[0], k = zr[768], v = zr[1536];
    { const float qo = __shfl_xor(q, 8), ko = __shfl_xor(k, 8);
      if (lane < 16) { const float c = cs[8192 * 16 + (lane & 7)], s = cs[8192 * 16 + 8 + (lane & 7)], sg = lane < 8 ? -1.f : 1.f; q = q * c + sg * qo * s; k = k * c + sg * ko * s; } }
    const size_t cb = ((size_t)(layer * SB + b) * 2) * n * 256;
    const float* kc = cache + cb + h * 64; const float* vc = kc + (size_t)n * 256;
    if (wid == 0) { float* ok = outkv + cb + h * 64; float* ov = ok + (size_t)n * 256; ok[(size_t)(n - 1) * 256 + lane] = k; ov[(size_t)(n - 1) * 256 + lane] = v; }
    q *= C2;
    qs[lane] = q; qs[64 + lane] = v;
    const int kk = lane >> 2, qd = lane & 3, jg = lane >> 4, d4 = lane & 15;
    f32x4 kv4[4], vv4[4];
    { const float* kr = kc + (size_t)(n - dil * (1 + 16 * wid + kk)) * 256 + 16 * qd;
#pragma unroll
      for (int i = 0; i < 4; ++i) kv4[i] = *(const f32x4*)(kr + 4 * i);
#pragma unroll
      for (int i = 0; i < 4; ++i) vv4[i] = *(const f32x4*)(vc + (size_t)(n - dil * (1 + 16 * wid + 4 * jg + i)) * 256 + 4 * d4); }
    asm volatile("s_waitcnt lgkmcnt(0)" ::: "memory");
    float a = 0.f;
#pragma unroll
    for (int i = 0; i < 4; ++i) { const f32x4 qv = *(const LAS f32x4*)(qs + 16 * qd + 4 * i); a += (kv4[i][0] * qv[0] + kv4[i][1] * qv[1]) + (kv4[i][2] * qv[2] + kv4[i][3] * qv[3]); }
    a += __shfl_xor(a, 1); a += __shfl_xor(a, 2);
    float m = wave_max(a), snew = 0.f;
    if (wid == 0) { snew = wave_sum(q * k); m = fmaxf(m, snew); }
    const float p = __builtin_amdgcn_exp2f(a - m);
    float lsum = wave_sum(p) * 0.25f, pn = 0.f;
    if (wid == 0) { pn = __builtin_amdgcn_exp2f(snew - m); lsum += pn; }
    f32x4 oacc = {0.f, 0.f, 0.f, 0.f};
#pragma unroll
    for (int i = 0; i < 4; ++i) { const float pp = __shfl(p, (4 * jg + i) * 4); oacc += vv4[i] * pp; }
#pragma unroll
    for (int i = 0; i < 4; ++i) { oacc[i] += __shfl_xor(oacc[i], 16); oacc[i] += __shfl_xor(oacc[i], 32); }
    if (jg == 0) { const f32x4 vn = *(const LAS f32x4*)(qs + 64 + 4 * d4); *(LAS f32x4*)(sh + wid * 72 + 4 * d4) = oacc + vn * pn; }
    if (lane == 0) { sh[wid * 72 + 64] = m; sh[wid * 72 + 65] = lsum; }
    __syncthreads();
    if (wid == 0) {
        float M = sh[64];
#pragma unroll
        for (int w = 1; w < 8; ++w) M = fmaxf(M, sh[w * 72 + 64]);
        float L = 0.f, o = 0.f;
#pragma unroll
        for (int w = 0; w < 8; ++w) { const float f = __builtin_amdgcn_exp2f(sh[w * 72 + 64] - M); L += sh[w * 72 + 65] * f; o += sh[w * 72 + lane] * f; }
        ogs[b * 768 + g * 256 + h * 64 + lane] = o / L;
        if (lane == 0) lses[b * 12 + g * 4 + h] = M + __builtin_amdgcn_logf(L);
    }
    __syncthreads();
}

constexpr int P3_UROWS = 32 + CW - 1, P3_TAPS = 36  , P3_OFF_W = 64 * CONV * 2  , P3_OFF_C = P3_OFF_W + P3_TAPS * CONV * 2, P3_OFF_RED = P3_OFF_C + 3 * CONV * 4;
static_assert(P3_OFF_RED + 64 <= LDS_BYTES, "phase 3 LDS map");
__device__ __forceinline__ void p3_stage_weights(LAS unsigned char* lds, int layer, const float* conv_w, const float* conv_b, const float* ln_g, const float* ln_b, int tid) {
    const f32x4* cw4 = (const f32x4*)(conv_w + (size_t)layer * CW * CONV);
    f32x4 wv[12];
#pragma unroll
    for (int j = 0; j < 12; ++j) { const int i = tid + 512 * j; if (i < CW * 192) wv[j] = cw4[i]; }
#pragma unroll
    for (int j = 0; j < 12; ++j) { const int i = tid + 512 * j; if (i < CW * 192) { u32x2 p; p.x = pk2(wv[j][0], wv[j][1]); p.y = pk2(wv[j][2], wv[j][3]); ((LAS u32x2*)(lds + P3_OFF_W))[i] = p; } }
    unsigned zz = 0u; asm volatile("" : "+v"(zz));
    for (int i = tid; i < (P3_TAPS - CW) * 192; i += 512) ((LAS u32x2*)(lds + P3_OFF_W))[CW * 192 + i] = (u32x2){zz, zz};
    if (tid < 192) { ((LAS u32x4*)(lds + P3_UROWS * CONV * 2))[tid] = (u32x4){zz, zz, zz, zz};
        LAS f32x4* c4 = (LAS f32x4*)(lds + P3_OFF_C); c4[tid] = ((const f32x4*)(conv_b + layer * CONV))[tid]; c4[192 + tid] = ((const f32x4*)(ln_g + layer * CONV))[tid]; c4[384 + tid] = ((const f32x4*)(ln_b + layer * CONV))[tid]; }
}
#define P3_LOAD(V, TILE) { const size_t row0_ = (size_t)(TILE) * 32; const int b_ = (int)(row0_ >> 13), s0_ = (int)(row0_ & 8191); \
        _Pragma("unroll") for (int i = 0; i < 12; ++i) { const int idx = tid + 512 * i, ri = idx / 96, c16 = idx - ri * 96, sp = s0_ - (CW - 1) + ri; V[i] = (u32x4){0u, 0u, 0u, 0u}; \
            if (idx < P3_UROWS * 96 && sp >= 0) V[i] = *(const u32x4*)(Ub + ((size_t)(b_ << 13) + sp) * 768 + c16 * 8); } }
#define P3_TO_LDS(V) { _Pragma("unroll") for (int i = 0; i < 12; ++i) { const int idx = tid + 512 * i; if (idx < P3_UROWS * 96) *(LAS u32x4*)(lds + idx * 16) = V[i]; } }
template <int NT>
__device__ __forceinline__ void p3_merge(size_t rw, const bf16* OG, const float* LSE, bf16* CAT, int lane) {
    const int h = lane >> 4, d4 = (lane & 15) * 4;
    float l0[NT], l1[NT], l2[NT]; u32x2 a0[NT], a1[NT], a2[NT];
#pragma unroll
    for (int tk = 0; tk < NT; ++tk) { const size_t row = rw + tk; l0[tk] = LSE[row * 12 + h]; l1[tk] = LSE[row * 12 + 4 + h]; l2[tk] = LSE[row * 12 + 8 + h];
        a0[tk] = *(const u32x2*)(OG + row * 768 + h * 64 + d4); a1[tk] = *(const u32x2*)(OG + row * 768 + 256 + h * 64 + d4); a2[tk] = *(const u32x2*)(OG + row * 768 + 512 + h * 64 + d4); }
#pragma unroll
    for (int tk = 0; tk < NT; ++tk) {
        const float lm = fmaxf(l0[tk], fmaxf(l1[tk], l2[tk])); const float w0 = __builtin_amdgcn_exp2f(l0[tk] - lm), w1 = __builtin_amdgcn_exp2f(l1[tk] - lm), w2 = __builtin_amdgcn_exp2f(l2[tk] - lm); const float wi = 1.f / (w0 + w1 + w2);
        const f32x4 f0 = {bflo(a0[tk].x), bfhi(a0[tk].x), bflo(a0[tk].y), bfhi(a0[tk].y)}, f1 = {bflo(a1[tk].x), bfhi(a1[tk].x), bflo(a1[tk].y), bfhi(a1[tk].y)}, f2 = {bflo(a2[tk].x), bfhi(a2[tk].x), bflo(a2[tk].y), bfhi(a2[tk].y)};
        st4bf(CAT + (rw + tk) * 1024 + h * 64 + d4, (f0 * w0 + f1 * w1 + f2 * w2) * wi);
    }
}
__device__ __forceinline__ void p3_conv(LAS unsigned char* lds, int tile, bf16* CAT, int lane, int wid) {
    const size_t rw = (size_t)tile * 32 + 4 * wid;
    const f32x4 zero4 = {0.f, 0.f, 0.f, 0.f};
    const LAS f32x4* c4 = (const LAS f32x4*)(lds + P3_OFF_C);
    f32x4 acc[3][4];
#pragma unroll
    for (int k = 0; k < 3; ++k) {
        const int cq = lane + 64 * k;
        const LAS unsigned char* up = lds + (4 * wid) * (CONV * 2) + cq * 8;
        const LAS unsigned char* wp = lds + P3_OFF_W + cq * 8;
        const f32x4 bias = c4[cq];
        acc[k][0] = bias; acc[k][1] = bias; acc[k][2] = bias; acc[k][3] = bias;
        f32x4 wa = zero4, wb = zero4, wc = zero4, wd = zero4;
#define CONV_STEP(I, WNEW, W1, W2, W3) { const u32x2 wr_ = *(const LAS u32x2*)(wq + (I) * (CONV * 2)); WNEW = (f32x4){bflo(wr_.x), bfhi(wr_.x), bflo(wr_.y), bfhi(wr_.y)}; \
            const u32x2 ux_ = *(const LAS u32x2*)(uq + (I) * (CONV * 2)); const f32x4 uv_ = {bflo(ux_.x), bfhi(ux_.x), bflo(ux_.y), bfhi(ux_.y)}; \
            acc[k][0] += uv_ * WNEW; acc[k][1] += uv_ * W1; acc[k][2] += uv_ * W2; acc[k][3] += uv_ * W3; }
        const LAS unsigned char* uq = up; const LAS unsigned char* wq = wp;
#pragma unroll 3
        for (int w = 0; w < P3_TAPS; w += 4) {
            CONV_STEP(0, wa, wd, wc, wb) CONV_STEP(1, wb, wa, wd, wc) CONV_STEP(2, wc, wb, wa, wd) CONV_STEP(3, wd, wc, wb, wa)
            uq += 4 * CONV * 2; wq += 4 * CONV * 2;
        }
#undef CONV_STEP
    }
#pragma unroll
    for (int o = 0; o < 4; ++o) {
        float sm = 0.f;
#pragma unroll
        for (int k = 0; k < 3; ++k) sm += (acc[k][o][0] + acc[k][o][1]) + (acc[k][o][2] + acc[k][o][3]);
        const float mu = wave_sum(sm) * (1.f / CONV); float sq = 0.f;
#pragma unroll
        for (int k = 0; k < 3; ++k) { const f32x4 d = acc[k][o] - mu; acc[k][o] = d; sq += (d[0] * d[0] + d[1] * d[1]) + (d[2] * d[2] + d[3] * d[3]); }
        const float rstd = rsqrtf(wave_sum(sq) * (1.f / CONV) + 1e-5f);
#pragma unroll
        for (int k = 0; k < 3; ++k) { const int cq = lane + 64 * k; f32x4 y = acc[k][o] * rstd * c4[192 + cq] + c4[384 + cq];
#pragma unroll
            for (int i = 0; i < 4; ++i) y[i] = y[i] * __builtin_amdgcn_rcpf(1.f + __expf(-y[i]));
            st4bf(CAT + (rw + o) * 1024 + 256 + 4 * cq, y); }
    }
}
__device__ __forceinline__ void sconv_item(int layer, int b, int k, const float* zs, const float* state, float* outconv, const float* conv_w, const float* conv_b, float* cvs, int lane) {
    const int c = 64 * k + lane, zc = 2304 + 256 * (c >> 7) + (c & 127);
    const float* st = state + (size_t)(layer * SB + b) * 30 * CONV + c; const float* cwp = conv_w + (size_t)layer * CW * CONV + c;
    float sv[30], wv[31];
#pragma unroll
    for (int w = 0; w < 30; ++w) { sv[w] = st[w * CONV]; wv[w] = cwp[w * CONV]; }
    wv[30] = cwp[30 * CONV];
    const float a = zs[b * DIN + zc], gt = zs[b * DIN + zc + 128]; const float u = a * __builtin_amdgcn_rcpf(1.f + __expf(-gt));
    outconv[((size_t)(layer * SB + b) * 30 + 29) * CONV + c] = u;
    float acc = conv_b[layer * CONV + c] + u * wv[30];
#pragma unroll
    for (int w = 0; w < 30; ++w) acc += sv[w] * wv[w];
    cvs[b * CONV + c] = acc;
}
__device__ __forceinline__ void p3_sample(LAS unsigned char* lds, int layer, int b, const float* ogs, const float* lses, bf16* cats, const float* cvs, const float* ln_g, const float* ln_b, int tid, int lane, int wid) {
    LAS float* red = (LAS float*)(lds + P3_OFF_RED);
    if (tid < 256) {
        const int h = tid >> 6, d = tid & 63;
        const float l0 = lses[b * 12 + h], l1 = lses[b * 12 + 4 + h], l2 = lses[b * 12 + 8 + h];
        const float lm = fmaxf(l0, fmaxf(l1, l2)); const float w0 = __builtin_amdgcn_exp2f(l0 - lm), w1 = __builtin_amdgcn_exp2f(l1 - lm), w2 = __builtin_amdgcn_exp2f(l2 - lm);
        const float att = (ogs[b * 768 + tid] * w0 + ogs[b * 768 + 256 + tid] * w1 + ogs[b * 768 + 512 + tid] * w2) / (w0 + w1 + w2);
        cats[b * 1024 + h * 64 + d] = (bf16)(pk2(att, 0.f) & 0xffffu);
    }
    float cv[2]; float sm = 0.f;
#pragma unroll
    for (int e = 0; e < 2; ++e) { const int c = tid + 512 * e; cv[e] = 0.f; if (c < CONV) { cv[e] = cvs[b * CONV + c]; sm += cv[e]; } }
    sm = wave_sum(sm); if (lane == 0) red[wid] = sm;
    __syncthreads();
    float mu = 0.f;
#pragma unroll
    for (int w = 0; w < 8; ++w) mu += red[w];
    mu *= (1.f / CONV);
    float sq = 0.f;
#pragma unroll
    for (int e = 0; e < 2; ++e) { const int c = tid + 512 * e; if (c < CONV) { const float d = cv[e] - mu; sq += d * d; } }
    sq = wave_sum(sq); if (lane == 0) red[8 + wid] = sq;
    __syncthreads();
    float var = 0.f;
#pragma unroll
    for (int w = 0; w < 8; ++w) var += red[8 + w];
    const float rstd = rsqrtf(var * (1.f / CONV) + 1e-5f);
#pragma unroll
    for (int e = 0; e < 2; ++e) { const int c = tid + 512 * e; if (c < CONV) { float y = (cv[e] - mu) * rstd * ln_g[layer * CONV + c] + ln_b[layer * CONV + c]; y = y * __builtin_amdgcn_rcpf(1.f + __expf(-y)); cats[b * 1024 + 256 + c] = (bf16)(pk2(y, 0.f) & 0xffffu); } }
    __syncthreads();
}
#define XB_TMO      128
#define XB_XCNT(j)  (256  + 64 * (j))
#define XB_XSUB(j)  (1280 + 64 * (j))
#define XB_XGEN(j)  (2304 + 64 * (j))
#define XB_TOP      3328
#define XB_TOPGEN   3392
#define XCD_BAR_WORDS 3456
#define XB_SPIN_CAP (1u << 18)

__device__ __forceinline__ unsigned xb_ld(unsigned* p)              { return __hip_atomic_load(p, __ATOMIC_RELAXED, __HIP_MEMORY_SCOPE_AGENT); }
__device__ __forceinline__ unsigned xb_add(unsigned* p, unsigned v) { return __hip_atomic_fetch_add(p, v, __ATOMIC_RELAXED, __HIP_MEMORY_SCOPE_AGENT); }
__device__ __forceinline__ unsigned xb_xcc_id() { return (unsigned)__builtin_amdgcn_s_getreg((3 << 11) | 20) & 0xFu; }
#define XB_SPIN(cond, bar) do { unsigned _sp = 0; while (cond) { __builtin_amdgcn_s_sleep(1); \
    if ((++_sp & 255u) == 0u) { if (xb_ld(&(bar)[XB_TMO])) break; if (_sp > XB_SPIN_CAP) { atomicAdd(&(bar)[XB_TMO], 1u); break; } } } } while (0)

struct XcdBarrier {
    unsigned* bar; unsigned x;
    volatile LAS unsigned* st;
};

__device__ __forceinline__ XcdBarrier xcd_barrier_post(unsigned* bar, volatile LAS unsigned* st) {
    XcdBarrier b; b.bar = bar; b.x = xb_xcc_id(); b.st = st;
    if (threadIdx.x == 0) (void)xb_add(&bar[XB_XCNT(b.x)], 1u);
    return b;
}
__device__ __forceinline__ void xcd_barrier_complete(unsigned* bar, unsigned x, unsigned& nloc, unsigned& nx) {
    const unsigned G = gridDim.x * gridDim.y * gridDim.z;
    unsigned sum, cnt, mine, sp = 0u;
    for (;;) {
        sum = 0u; cnt = 0u; mine = 0u;
#pragma unroll
        for (unsigned j = 0; j < 16; ++j) { const unsigned c = xb_ld(&bar[XB_XCNT(j)]); sum += c; cnt += (c > 0u) ? 1u : 0u; mine = (j == x) ? c : mine; }
        if (sum == G) break;
        __builtin_amdgcn_s_sleep(1);
        if ((++sp & 255u) == 0u) { if (xb_ld(&bar[XB_TMO])) break; if (sp > XB_SPIN_CAP) { atomicAdd(&bar[XB_TMO], 1u); break; } }
    }
    nloc = mine > 0u ? mine : 1u; nx = cnt > 0u ? cnt : 1u;
}

__device__ __forceinline__ void xcd_barrier(const XcdBarrier& b) {
    asm volatile("s_waitcnt vmcnt(0)" ::: "memory");
    __syncthreads();
    if (threadIdx.x == 0) {
        unsigned* bar = b.bar;
        __builtin_amdgcn_s_waitcnt(0);
        unsigned nloc = b.st[0], nx = b.st[1];
        if (nloc == 0u) { xcd_barrier_complete(bar, b.x, nloc, nx); b.st[0] = nloc; b.st[1] = nx; }
        const unsigned old = xb_add(&bar[XB_XSUB(b.x)], 1u);
        const unsigned gen = old / nloc;
        if (old + 1u == (gen + 1u) * nloc) {
            __builtin_amdgcn_fence(__ATOMIC_RELEASE, "agent");
            asm volatile("s_waitcnt vmcnt(0)" ::: "memory");
            const unsigned og = xb_add(&bar[XB_TOP], 1u);
            const unsigned tg = og / nx;
            if (og + 1u == (tg + 1u) * nx) xb_add(&bar[XB_TOPGEN], 1u);
            else XB_SPIN(xb_ld(&bar[XB_TOPGEN]) == tg, bar);
            __builtin_amdgcn_fence(__ATOMIC_ACQUIRE, "agent");
            xb_add(&bar[XB_XGEN(b.x)], 1u);
            asm volatile("s_waitcnt vmcnt(0)" ::: "memory");
        } else {
            XB_SPIN(xb_ld(&bar[XB_XGEN(b.x)]) == gen, bar);
            __builtin_amdgcn_fence(__ATOMIC_ACQUIRE, "agent");
            asm volatile("s_waitcnt vmcnt(0)" ::: "memory");
        }
    }
    __syncthreads();
}
struct Args { const float* in[17]; float* out; unsigned char* ws; double inv[8]; };
typedef const __attribute__((address_space(4))) Args* KArgs;
#define KARGS(kp) KArgs kp = (KArgs)__builtin_amdgcn_kernarg_segment_ptr(); asm volatile("" : "+s"(kp))
#define IDS() int tid_ = threadIdx.x, G_ = (int)gridDim.x, bx_ = (int)blockIdx.x; asm volatile("" : "+v"(tid_), "+s"(G_), "+s"(bx_)); \
    const int tid = tid_, lane = tid & 63, wid = __builtin_amdgcn_readfirstlane(tid >> 6), G = G_, bx = bx_; (void)lane; (void)wid; (void)G; (void)bx
struct LayerW { const bf16 *in, *o, *up, *dn; };
__device__ __forceinline__ unsigned char* wl_of(unsigned char* ws, int layer) { return ws + WS_W + (size_t)layer * W_LSTRIDE; }

__device__ __forceinline__ void phase0(LAS unsigned char* lds) {
    KARGS(kp); IDS();
    const int gw = bx * 8 + wid, NGW = G * 8; const size_t gtid = (size_t)bx * 512 + tid, nthr = (size_t)G * 512;
    unsigned char* ws = kp->ws; float* out = kp->out;
    LAS float* scr = (LAS float*)(lds + wid * 16384);
    constexpr int I_IN = 16 * 120, I_O = 16 * 32, I_UP = 16 * 128, I_DN = 64 * 32, I_L = I_IN + I_O + I_UP + I_DN;
    for (int it = gw; it < DEPTH * I_L; it += NGW) {
        const int l = it / I_L; int r = it - l * I_L;
        unsigned char* wl = wl_of(ws, l);
        if (r < I_IN) { const int kb = r / 120, nb = r % 120; p0_transpose_item(kp->in[6] + (size_t)l * D * DIN, D, DIN, win_srccol(32 * nb), kp->in[12] + l * D, (bf16*)(wl + W_IN), 32 * nb, scr, 64 * kb, lane); continue; } r -= I_IN;
        if (r < I_O) { const int kb = r / 32, nb = r % 32; p0_transpose_item(kp->in[7] + (size_t)l * D * D, D, D, 32 * nb, nullptr, (bf16*)(wl + W_O), 32 * nb, scr, 64 * kb, lane); continue; } r -= I_O;
        if (r < I_UP) { const int kb = r / 128, nb = r % 128; p0_transpose_item(kp->in[14] + (size_t)l * D * DFF, D, DFF, 32 * nb, kp->in[13] + l * D, (bf16*)(wl + W_UP), 32 * nb, scr, 64 * kb, lane); continue; } r -= I_UP;
        { const int kb = r / 32, nb = r % 32; p0_transpose_item(kp->in[15] + (size_t)l * DFF * D, DFF, D, 32 * nb, nullptr, (bf16*)(wl + W_DN), 32 * nb, scr, 64 * kb, lane); }
    }
    {
        const float* x_prompt = kp->in[0]; const float* x_sample = kp->in[1];
        bf16* XB = (bf16*)(ws + WS_XB); float* SSQ = (float*)(ws + WS_SSQ); unsigned char* sm = ws + WS_SMALL;
        float* XS = (float*)(sm + SM_XS); bf16* XSB = (bf16*)(sm + SM_XSB); float* SSQS = (float*)(sm + SM_SSQS);
        for (int m0 = gw; m0 < MP + SB; m0 += 4 * NGW) {
            f32x4 v[4][4];
#pragma unroll
            for (int u = 0; u < 4; ++u) { const int m = m0 + u * NGW; const bool smp = m >= MP; const int mr = smp ? m - MP : m;
                if (m < MP + SB) { const f32x4* xr = (const f32x4*)((smp ? x_sample : x_prompt) + (size_t)mr * D) + lane;
#pragma unroll
                    for (int j = 0; j < 4; ++j) v[u][j] = __builtin_nontemporal_load(xr + 64 * j); } }
#pragma unroll
            for (int u = 0; u < 4; ++u) { const int m = m0 + u * NGW; const bool smp = m >= MP; const int mr = smp ? m - MP : m;
                if (m < MP + SB) { bf16* orow = (smp ? XSB : XB) + (size_t)mr * D; float q = 0.f;
#pragma unroll
                    for (int j = 0; j < 4; ++j) { const f32x4 x = v[u][j]; q += (x[0] * x[0] + x[1] * x[1]) + (x[2] * x[2] + x[3] * x[3]); st4bf(orow + 4 * lane + 256 * j, x); if (smp) *(f32x4*)(XS + (size_t)mr * D + 4 * lane + 256 * j) = x; }
                    q = wave_sum(q);
                    if (smp) SSQS[mr * 64 + lane] = lane == 0 ? q : 0.f;
                    else if (lane < 16) SSQ[(size_t)mr * 16 + lane] = lane == 0 ? q : 0.f; } }
        }
    }
    {
        float* CS = (float*)(ws + WS_CS);
        for (size_t i = gtid; i < (size_t)8193 * 8; i += nthr) {
            const int p = (int)(i >> 3), f = (int)(i & 7); const double pos = p < 8192 ? (double)p : (double)PAST;
            double rev = pos * kp->inv[f] * 0.15915494309189535; rev -= __builtin_rint(rev);
            const float fr = (float)rev; CS[p * 16 + f] = __builtin_amdgcn_cosf(fr); CS[p * 16 + 8 + f] = __builtin_amdgcn_sinf(fr);
        }
    }
    { const float* in0 = kp->in[2]; const float* in1 = kp->in[3]; const float* in2 = kp->in[4];
#pragma unroll 1
      for (int ch = (G == 256 ? CH_P0 : 0) + gw; ch < NCHUNK; ch += NGW) { f32x4 cv[8]; unsigned okm; CPY_LOAD(cv, okm, ch, in0, in1, in2) CPY_STORE(cv, okm, ch, out) } }
    { const f32x4* st4 = (const f32x4*)kp->in[5]; f32x4* oc4 = (f32x4*)(out + O_CS);
      for (size_t i = gtid; i < (size_t)DEPTH * SB * 30 * (CONV / 4); i += nthr) { const unsigned w = (unsigned)(i % (30 * (CONV / 4))); if (w < 29 * (CONV / 4)) oc4[i] = st4[i + CONV / 4]; } }
}

__device__ __forceinline__ void phase1(LAS unsigned char* lds, int layer) {
    KARGS(kp); IDS();
    unsigned char* ws = kp->ws; unsigned char* sm = ws + WS_SMALL;
    const bf16* Win_t = (const bf16*)(wl_of(ws, layer) + W_IN);
    pg8::Gemm g{(const bf16*)(ws + WS_XB), Win_t, MP, DIN, D}; pg8::StaticOrder S; S.init(MP, DIN, G, bx);
    pg8::EpiIn E{(const float*)(ws + WS_SSQ), (const float*)(ws + WS_CS), (bf16*)(ws + WS_Q), (WS_K - WS_Q) / 2, (bf16*)(ws + WS_U)};
    SEpiIn SE{(const float*)(sm + SM_SSQS), (float*)(sm + SM_ZS)};
    small_gemm(lds, (const bf16*)(sm + SM_XSB), Win_t, DIN, D, G / 2, G - G / 2, SE);
    pg8::gemm_phase<pg8::EpiIn, pg8::StaticOrder, true, true>(lds, g, S, E);
    if (G == 256 && bx >= 128) {
        const float* in0 = kp->in[2]; const float* in1 = kp->in[3]; const float* in2 = kp->in[4]; float* outp = kp->out;
        const int c0 = CH_P2 + layer * (NB * 12 * 256) + ((bx - 128) * 8 + wid) * (P1_CHUNKS / 1024);
#pragma unroll 1
        for (int j = 0; j < P1_CHUNKS / 1024; j += 2) {
            f32x4 ca[8], cb[8]; unsigned ma, mb;
            CPY_LOAD(ca, ma, c0 + j, in0, in1, in2) CPY_LOAD(cb, mb, c0 + j + 1, in0, in1, in2)
            CPY_STORE(ca, ma, c0 + j, outp) CPY_STORE(cb, mb, c0 + j + 1, outp)
        }
    }
}

__device__ __forceinline__ void phase2(LAS unsigned char* lds, int layer) {
    KARGS(kp); IDS();
    unsigned char* ws = kp->ws; unsigned char* sm = ws + WS_SMALL; float* out = kp->out;
    const int gw = bx * 8 + wid, NGW = G * 8;
    LAS unsigned char* vst = lds + wid * 8192;
    const bf16* Qb = (const bf16*)(ws + WS_Q); bf16* OGb = (bf16*)(ws + WS_OG); const bf16* Kb = (const bf16*)(ws + WS_K); const bf16* Vb = (const bf16*)(ws + WS_V); float* LSE = (float*)(ws + WS_LSE);
#ifndef NO_2A
    { const float* in0 = kp->in[2]; const float* in1 = kp->in[3]; const float* in2 = kp->in[4]; const bool ride = G == 256;
      const int r32 = lane & 31, hi = lane >> 5; constexpr int NR = NB * 12 * 256 / 8;
      u32x4 pc[12]; bf16x8 qn[4], qr[4];
      int R = bx;
      if (R < NR) { const AttRound A = att_round(R); ATT_STAGE_LOAD(pc, qn, A) }
#pragma unroll 1
      for (; R < NR; R += G) {
          const AttRound A = att_round(R);
          ATT_STAGE_STORE(pc)
#pragma unroll
          for (int d0 = 0; d0 < 4; ++d0) qr[d0] = qn[d0];
          __syncthreads();
          if (R + G < NR) { const AttRound An = att_round(R + G); ATT_STAGE_LOAD(pc, qn, An) }
          f32x4 cv[8]; unsigned okm = 0u; const int ch = CH_P2 + layer * (NB * 12 * 256) + R * 8 + wid;
          if (ride && R * 8 + wid >= P1_CHUNKS) CPY_LOAD(cv, okm, ch, in0, in1, in2)
          attn_compute(lds, qr, OGb, LSE, A, wid, lane);
          CPY_STORE(cv, okm, ch, out)
          __syncthreads();
      } }
#pragma unroll 1
    for (int si = bx; si < SB * 12; si += G) { const int b = si / 12, hg = si - b * 12, g = hg >> 2, h = hg & 3;
        const float* cache = g == 0 ? kp->in[2] : (g == 1 ? kp->in[3] : kp->in[4]); float* okv = out + (g == 0 ? O_KS0 : (g == 1 ? O_KS1 : O_KS2));
        sattn_block(lds, (const float*)(sm + SM_ZS), (const float*)(ws + WS_CS), cache, okv, (float*)(sm + SM_OGS), (float*)(sm + SM_LSES), layer, b, h, g, lane, wid); }
    if (wid == 2 || wid == 3) { for (int si = (wid - 2) * G + bx; si < SB * 12; si += 2 * G) sconv_item(layer, si / 12, si % 12, (const float*)(sm + SM_ZS), kp->in[5], out + O_CS, kp->in[8], kp->in[9], (float*)(sm + SM_CVS), lane); }
#endif
#ifndef NO_2C
    {
        const size_t gtid = (size_t)bx * 512 + tid, nthr = (size_t)G * 512;
        const bf16* Ub = (const bf16*)(ws + WS_U);
#pragma unroll 1
        for (int g = 0; g < 3; ++g) {
            const int keep = 128 << (2 * g); float* ob = out + (g == 0 ? O_KP0 : (g == 1 ? O_KP1 : O_KP2)) + (size_t)layer * NB * 2 * keep * 256;
            const int total = NB * 2 * keep * 64, lk = 7 + 2 * g;
            for (int i = (int)gtid; i < total; i += (int)nthr) {
                const int c4 = i & 63, rr = i >> 6, j = rr & (keep - 1), bk = rr >> lk, kv = bk & 1, b = bk >> 1;
                const bf16* src = (kv ? Vb : Kb) + ((size_t)b * SEQ + (SEQ - keep) + j) * 768 + g * 256 + c4 * 4;
                __builtin_nontemporal_store(ld4bf(src), (f32x4*)(ob + (size_t)i * 4));
            }
        }
        float* oc = out + O_CP + (size_t)layer * NB * 30 * CONV;
        for (size_t i = gtid; i < (size_t)NB * 30 * (CONV / 4); i += nthr) {
            const int c4 = (int)(i % (CONV / 4)); const size_t rr = i / (CONV / 4); const int j = (int)(rr % 30), b = (int)(rr / 30);
            *(f32x4*)(oc + i * 4) = ld4bf(Ub + ((size_t)b * SEQ + (SEQ - 30) + j) * 768 + c4 * 4);
        }
    }
#endif
}

__device__ __forceinline__ void phase3(LAS unsigned char* lds, int layer) {
    KARGS(kp); IDS();
    unsigned char* ws = kp->ws; unsigned char* sm = ws + WS_SMALL;
    p3_stage_weights(lds, layer, kp->in[8], kp->in[9], kp->in[10], kp->in[11], tid);
    {
        const bf16* Ub = (const bf16*)(ws + WS_U); const bf16* OGb = (const bf16*)(ws + WS_OG); const float* LSE = (const float*)(ws + WS_LSE); bf16* CAT = (bf16*)(ws + WS_CAT);
        u32x4 v[12];
        int tile = bx;
        const float* in0 = kp->in[2]; const float* in1 = kp->in[3]; const float* in2 = kp->in[4]; float* outp = kp->out;
        if (tile < MP / 32) P3_LOAD(v, tile)
#pragma unroll 1
        for (int t2 = bx; t2 < MP / 32; t2 += 2 * G) {
            p3_merge<4>((size_t)t2 * 32 + 4 * wid, OGb, LSE, CAT, lane);
            if (t2 + G < MP / 32) p3_merge<4>((size_t)(t2 + G) * 32 + 4 * wid, OGb, LSE, CAT, lane);
        }
#pragma unroll 1
        for (; tile < MP / 32; tile += G) {
            P3_TO_LDS(v)
            __syncthreads();
            if (tile + G < MP / 32) P3_LOAD(v, tile + G)
            f32x4 cv[8]; unsigned okm = 0u; const int ch = CH_P3 + ((layer * 4 + (tile - bx) / G) * 256 + bx) * 8 + wid;
            if (G == 256) CPY_LOAD(cv, okm, ch, in0, in1, in2)
            p3_conv(lds, tile, CAT, lane, wid);
            CPY_STORE(cv, okm, ch, outp)
            __syncthreads();
        }
    }
    if (bx < SB) p3_sample(lds, layer, bx, (const float*)(sm + SM_OGS), (const float*)(sm + SM_LSES), (bf16*)(sm + SM_CATS), (const float*)(sm + SM_CVS), kp->in[10], kp->in[11], tid, lane, wid);
}

__device__ __forceinline__ void phase4(LAS unsigned char* lds, int layer, bool do_small = true) {
    KARGS(kp); IDS();
    unsigned char* ws = kp->ws; unsigned char* sm = ws + WS_SMALL;
    const bf16* Wo_t = (const bf16*)(wl_of(ws, layer) + W_O);
    pg8::Gemm g{(const bf16*)(ws + WS_CAT), Wo_t, MP, D, D}; pg8::StaticOrder S; S.init(MP, D, G, bx);
    pg8::EpiRes E{(bf16*)(ws + WS_XB), (float*)(ws + WS_SSQ)};
    SEpiRes SE{(float*)(sm + SM_XS), (bf16*)(sm + SM_XSB), (float*)(sm + SM_SSQS)};
    if (do_small) small_gemm(lds, (const bf16*)(sm + SM_CATS), Wo_t, D, D, 0, G, SE);
    pg8::gemm_phase<pg8::EpiRes, pg8::StaticOrder, true, true>(lds, g, S, E);
}

__device__ __forceinline__ void phase5(LAS unsigned char* lds, int layer) {
    KARGS(kp); IDS();
    unsigned char* ws = kp->ws; unsigned char* sm = ws + WS_SMALL;
    const bf16* Wup_t = (const bf16*)(wl_of(ws, layer) + W_UP);
    pg8::Gemm g{(const bf16*)(ws + WS_XB), Wup_t, MP, DFF, D}; pg8::StaticOrder S; S.init(MP, DFF, G, bx);
    pg8::EpiUp E{(const float*)(ws + WS_SSQ), (bf16*)(ws + WS_F)};
    SEpiUp SE{(const float*)(sm + SM_SSQS), (bf16*)(sm + SM_FS)};
    small_gemm(lds, (const bf16*)(sm + SM_XSB), Wup_t, DFF, D, 0, G, SE);
    pg8::gemm_phase<pg8::EpiUp, pg8::StaticOrder, true, true>(lds, g, S, E);
}

__device__ __forceinline__ void phase6(LAS unsigned char* lds, int layer, bool do_small = true) {
    KARGS(kp); IDS();
    unsigned char* ws = kp->ws; unsigned char* sm = ws + WS_SMALL;
    const bf16* Wdn_t = (const bf16*)(wl_of(ws, layer) + W_DN);
    pg8::Gemm g{(const bf16*)(ws + WS_F), Wdn_t, MP, D, DFF}; pg8::StaticOrder S; S.init(MP, D, G, bx);
    pg8::EpiRes E{(bf16*)(ws + WS_XB), (float*)(ws + WS_SSQ)};
    SEpiRes SE{(float*)(sm + SM_XS), (bf16*)(sm + SM_XSB), (float*)(sm + SM_SSQS)};
    if (do_small) small_gemm(lds, (const bf16*)(sm + SM_FS), Wdn_t, D, DFF, 0, G, SE);
    pg8::gemm_phase<pg8::EpiRes, pg8::StaticOrder, true, true>(lds, g, S, E);
}

__device__ __forceinline__ void phase7() {
    KARGS(kp); IDS();
    unsigned char* ws = kp->ws; unsigned char* sm = ws + WS_SMALL; float* out = kp->out;
    const int gw = bx * 8 + wid, NGW = G * 8;
    const float* SSQ = (const float*)(ws + WS_SSQ); const float* SSQS = (const float*)(sm + SM_SSQS); const float* XS = (const float*)(sm + SM_XS); const bf16* XB = (const bf16*)(ws + WS_XB);
    const f32x4* nf4 = (const f32x4*)kp->in[16];
#pragma unroll 1
    for (int m0 = gw; m0 < MP + SB; m0 += 4 * NGW) {
        f32x4 x[4][4]; float rs[4];
#pragma unroll
        for (int u = 0; u < 4; ++u) { const int m = m0 + u * NGW; const bool smp = m >= MP; const int mr = smp ? m - MP : m;
            if (m < MP + SB) {
                if (smp) rs[u] = SSQS[mr * 64 + lane]; else rs[u] = lane < 16 ? SSQ[(size_t)mr * 16 + lane] : 0.f;
                if (smp) { const f32x4* src = (const f32x4*)(XS + (size_t)mr * D) + lane;
#pragma unroll
                    for (int j = 0; j < 4; ++j) x[u][j] = src[64 * j]; }
                else { const bf16* src = XB + (size_t)mr * D + 4 * lane;
#pragma unroll
                    for (int j = 0; j < 4; ++j) x[u][j] = ld4bf(src + 256 * j); } } }
#pragma unroll
        for (int u = 0; u < 4; ++u) { const int m = m0 + u * NGW; const bool smp = m >= MP; const int mr = smp ? m - MP : m;
            if (m < MP + SB) {
                const float r = rsqrtf(wave_sum(rs[u]) * (1.f / 1024.f) + 1e-6f);
                f32x4* dst = (f32x4*)(smp ? out + O_YS + (size_t)mr * D : out + O_YP + (size_t)mr * D) + lane;
#pragma unroll
                for (int j = 0; j < 4; ++j) { const f32x4 nf = nf4[lane + 64 * j]; __builtin_nontemporal_store(x[u][j] * r * nf, dst + 64 * j); } } }
    }
}

constexpr size_t WS_BAR = 1 * MiB;
constexpr int ST_OFF = LDS_BYTES - 64;
__device__ __forceinline__ void seam(LAS unsigned char* lds) {
    KARGS(kp);
    XcdBarrier b; b.bar = (unsigned*)(kp->ws + WS_BAR); b.x = xb_xcc_id(); b.st = (volatile LAS unsigned*)(lds + ST_OFF);
    xcd_barrier(b);
}
#ifdef PH_ONLY
#define PH_ON(n) (PH_ONLY == (n))
#else
#define PH_ON(n) true
#endif
#ifndef REP_P2
#define REP_P2 1
#endif
#ifndef REP_P6L1
#define REP_P6L1 0
#endif
#ifndef REP_P4L0
#define REP_P4L0 0
#endif
#ifndef XSYNC
#define XSYNC 0
#endif
#ifndef REP_P0
#define REP_P0 1
#endif
#ifndef REP_P1
#define REP_P1 1
#endif
#ifndef REP_P3
#define REP_P3 1
#endif
#ifndef REP_P5
#define REP_P5 1
#endif
__global__ void __launch_bounds__(512, 2) hybrid_fwd(Args args) {
    extern __shared__ __attribute__((aligned(16))) unsigned char lds_raw[];
    LAS unsigned char* lds = (LAS unsigned char*)lds_raw;
    cg::grid_group grid = cg::this_grid();
    {
        KARGS(kp);
        if (threadIdx.x < 2) ((volatile LAS unsigned*)(lds + ST_OFF))[threadIdx.x] = 0u;
        __syncthreads();
        (void)xcd_barrier_post((unsigned*)(kp->ws + WS_BAR), (volatile LAS unsigned*)(lds + ST_OFF));
        if (kp->ws == nullptr) grid.sync();
    }
    for (int rep_ = 0; rep_ < REP_P0; ++rep_) { if (rep_) seam(lds); if (PH_ON(0)) phase0(lds); }
    seam(lds);
#pragma unroll 1
    for (int layer = 0; layer < DEPTH; ++layer) {
#pragma unroll 1
        for (int rep_ = 0; rep_ < REP_P1; ++rep_) { if (rep_) seam(lds); if (PH_ON(1)) phase1(lds, layer); }
        seam(lds);
#pragma unroll 1
        for (int rep_ = 0; rep_ < REP_P2; ++rep_) { if (rep_) seam(lds); if (PH_ON(2)) phase2(lds, layer); }
        seam(lds);
#pragma unroll 1
        for (int rep_ = 0; rep_ < REP_P3; ++rep_) { if (rep_) seam(lds); if (PH_ON(3)) phase3(lds, layer); }
        seam(lds);
        if (PH_ON(4)) phase4(lds, layer);
        seam(lds);
#pragma unroll 1
        for (int r4_ = 0; r4_ < REP_P4L0 && layer == 0; ++r4_) { phase4(lds, layer, false); seam(lds); }
#pragma unroll 1
        for (int rep_ = 0; rep_ < REP_P5; ++rep_) { if (rep_) seam(lds); if (PH_ON(5)) phase5(lds, layer); }
        seam(lds);
        if (PH_ON(6)) phase6(lds, layer);
        seam(lds);
#pragma unroll 1
        for (int r6_ = 0; r6_ < REP_P6L1 && layer == DEPTH - 1; ++r6_) { phase6(lds, layer, false); seam(lds); }
#pragma unroll 1
        for (int xs_ = 0; xs_ < XSYNC; ++xs_) seam(lds);
    }
    if (PH_ON(7)) phase7();
}

extern "C" void kernel_launch(void* const* d_in, const int* in_sizes, int n_in, void* d_out, int out_size, void* d_ws, size_t ws_size, hipStream_t stream) {
    static int grid = 0;
    if (grid == 0) {
        if (n_in != 17 || (size_t)out_size != O_END || ws_size < WS_END) { fprintf(stderr, "kernel_launch: unexpected shapes: n_in %d out %d ws %zu\n", n_in, out_size, ws_size); grid = -1; return; }
        int dev = 0, cus = 0, per_cu = 0;
        (void)hipGetDevice(&dev); (void)hipDeviceGetAttribute(&cus, hipDeviceAttributeMultiprocessorCount, dev);
        if (hipFuncSetAttribute((const void*)hybrid_fwd, hipFuncAttributeMaxDynamicSharedMemorySize, LDS_BYTES) != hipSuccess) { fprintf(stderr, "kernel_launch: hipFuncSetAttribute failed\n"); grid = -1; return; }
        if (hipOccupancyMaxActiveBlocksPerMultiprocessor(&per_cu, (const void*)hybrid_fwd, 512, LDS_BYTES) != hipSuccess || per_cu < 1) { fprintf(stderr, "kernel_launch: occupancy query says %d\n", per_cu); per_cu = 1; }
        (void)hipGetLastError();
        grid = cus;
    }
    if (grid < 0) return;
    if (hipMemsetAsync((char*)d_ws + WS_BAR, 0, XCD_BAR_WORDS * 4, stream) != hipSuccess) { fprintf(stderr, "kernel_launch: hipMemsetAsync failed\n"); return; }
    Args a{};
    for (int i = 0; i < 17; ++i) a.in[i] = (const float*)d_in[i];
    a.out = (float*)d_out; a.ws = (unsigned char*)d_ws;
    for (int i = 0; i < 8; ++i) a.inv[i] = pow(500000.0, -(double)i / 8.0);
    void* kargs[] = {&a};
    const hipError_t e = hipLaunchCooperativeKernel((const void*)hybrid_fwd, dim3(grid), dim3(512), kargs, LDS_BYTES, stream);
    if (e != hipSuccess) fprintf(stderr, "kernel_launch: cooperative launch failed: %s (grid %d)\n", hipGetErrorString(e), grid);
}
```
